# Optimizing an MI355X kernel written in HIP

```python
import math
import jax, jax.numpy as jnp
from jax import lax
import numpy as np

D_MODEL = 1024
BATCH = 8
SEQ = 2048
DEPTH = 2
DEC_BATCH = 128
DEC_SEQ = 1
PAST_LEN = 16384
PAGE_SIZE = 128

N_MIXERS = 2
N_S5 = (DEPTH + 1) // 2
N_HG = DEPTH // 2
S5_GROUP = 16
S5_GROUPS = D_MODEL // S5_GROUP
S5_STATE = 64
S5_DT_MIN = 0.001
S5_DT_MAX = 0.1
HG_DK = 128
HG_HEADS = D_MODEL // HG_DK
HG_DV = D_MODEL // HG_HEADS
HG_WIDTH = HG_HEADS * HG_DK
HG_CHUNK = 64
N_MEM = 256
MEM_HEADS = 4
MEM_HD = D_MODEL // MEM_HEADS
FFN_DIM = 2816
EPS = 1e-6

kernel_name = "hybrid_s5_hgrn2_macaron_memxattn_step"


def rmsnorm(x, g):
    xf = x.astype(jnp.float32)
    y = xf * lax.rsqrt(jnp.mean(xf * xf, axis=-1, keepdims=True) + EPS)
    return (y * g.astype(jnp.float32)).astype(x.dtype)


def swiglu(x, w_in, w_out):
    gate, up = jnp.split(x @ w_in, 2, axis=-1)
    return (jax.nn.silu(gate) * up) @ w_out


def s5_mixer(u, h0_re, h0_im, a_re, a_im, log_dt, b_re, b_im, c_re, c_im, d, w_glu):
    bsz, t, _ = u.shape
    f32 = jnp.float32
    ug = u.astype(f32).reshape(bsz, t, S5_GROUPS, S5_GROUP)
    lam = lax.complex(a_re.astype(f32), a_im.astype(f32))
    dt = jnp.exp(log_dt.astype(f32))[:, None]
    lam_bar = jnp.exp(lam * dt)
    b = lax.complex(b_re.astype(f32), b_im.astype(f32))
    b_bar = ((lam_bar - 1.0) / lam)[..., None] * b
    c = lax.complex(c_re.astype(f32), c_im.astype(f32))
    bu = jnp.einsum('btgc,gpc->btgp', ug.astype(jnp.complex64), b_bar)
    a_seq = jnp.broadcast_to(lam_bar, (1, t, S5_GROUPS, S5_STATE))

    def combine(e1, e2):
        a1, x1 = e1
        a2, x2 = e2
        return a1 * a2, a2 * x1 + x2

    a_cum, x_cum = lax.associative_scan(combine, (a_seq, bu), axis=1)
    h0 = lax.complex(h0_re.astype(f32), h0_im.astype(f32))
    h = x_cum + a_cum * h0[:, None]
    y = jnp.einsum('btgp,gcp->btgc', h, c).real + d.astype(f32) * ug
    y = jax.nn.gelu(y.reshape(bsz, t, D_MODEL))
    ya, yb = jnp.split(y @ w_glu.astype(f32), 2, axis=-1)
    out = ya * jax.nn.sigmoid(yb)
    h_last = h[:, -1]
    return out.astype(u.dtype), h_last.real.astype(h0_re.dtype), h_last.imag.astype(h0_im.dtype)


def hgrn2_chunked(q, k, v, logf, s0):
    bsz, t = q.shape[:2]
    c = min(HG_CHUNK, t)
    n = -(-t // c)
    pad = n * c - t

    def prep(a):
        if pad:
            a = jnp.pad(a, ((0, 0), (0, pad), (0, 0), (0, 0)))
        return a.reshape(bsz, n, c, a.shape[2], a.shape[3]).transpose(1, 0, 2, 3, 4)

    qs, ks, vs, gs = prep(q), prep(k), prep(v), prep(logf)
    pos = jnp.arange(c)
    causal = (pos[:, None] >= pos[None, :])[None, :, :, None, None]

    def step(s, inp):
        qc, kc, vc, gc = inp
        bcum = jnp.cumsum(gc, axis=1)
        btot = bcum[:, -1]
        o_inter = jnp.einsum('bthk,bhkv->bthv', qc * jnp.exp(bcum), s)
        diff = bcum[:, :, None] - bcum[:, None, :]
        decay = jnp.exp(jnp.where(causal, diff, -jnp.inf))
        att = jnp.einsum('bthk,bshk,btshk->bhts', qc, kc, decay)
        o_intra = jnp.einsum('bhts,bshv->bthv', att, vc)
        k_dec = kc * jnp.exp(btot[:, None] - bcum)
        s_new = jnp.exp(btot)[..., None] * s + jnp.einsum('bshk,bshv->bhkv', k_dec, vc)
        return s_new, o_inter + o_intra

    s_fin, o = lax.scan(step, s0.astype(jnp.float32), (qs, ks, vs, gs))
    o = o.transpose(1, 0, 2, 3, 4).reshape(bsz, n * c, HG_HEADS, HG_DV)[:, :t]
    return o, s_fin


def hgrn2_mixer(x, s0, lb, w_in, norm_g, w_out):
    bsz, t, _ = x.shape
    f32 = jnp.float32
    proj = (x @ w_in).astype(f32)
    q, fz, i_in, g = jnp.split(proj, [HG_WIDTH, 2 * HG_WIDTH, 2 * HG_WIDTH + HG_HEADS * HG_DV], axis=-1)
    q = jax.nn.silu(q)
    lbf = lb.astype(f32)
    logf = jnp.logaddexp(jnp.log(lbf), jnp.log1p(-lbf) + jax.nn.log_sigmoid(fz))
    k = -jnp.expm1(logf)
    heads = lambda a, dd: a.reshape(bsz, t, HG_HEADS, dd)
    o, s_fin = hgrn2_chunked(heads(q, HG_DK), heads(k, HG_DK), heads(i_in, HG_DV), heads(logf, HG_DK), s0)
    o = rmsnorm(o, norm_g).reshape(bsz, t, HG_HEADS * HG_DV) * jax.nn.silu(g)
    return o.astype(x.dtype) @ w_out, s_fin.astype(s0.dtype)


def mem_kv(mem, norm_g, w_kv):
    bsz = mem.shape[0]
    kk, vv = jnp.split(rmsnorm(mem, norm_g) @ w_kv, 2, axis=-1)
    return kk.reshape(bsz, N_MEM, MEM_HEADS, MEM_HD), vv.reshape(bsz, N_MEM, MEM_HEADS, MEM_HD)


def cross_attend(x, mk, mv, w_q, w_o):
    bsz, t, _ = x.shape
    q = (x @ w_q).reshape(bsz, t, MEM_HEADS, MEM_HD).astype(jnp.float32)
    s = jnp.einsum('bthd,bmhd->bhtm', q, mk.astype(jnp.float32)) * (1.0 / math.sqrt(MEM_HD))
    p = jax.nn.softmax(s, axis=-1)
    o = jnp.einsum('bhtm,bmhd->bthd', p, mv.astype(jnp.float32)).reshape(bsz, t, D_MODEL)
    return o.astype(x.dtype) @ w_o


def trunk(x, s5_re, s5_im, hg_s, mem_k, mem_v, lower_bounds, p):
    new_re, new_im, new_hg = [], [], []
    for i in range(DEPTH):
        j = i // N_MIXERS
        x = x + 0.5 * swiglu(rmsnorm(x, p['ffn1_norm'][i]), p['ffn1_w_in'][i], p['ffn1_w_out'][i])
        h = rmsnorm(x, p['mix_norm'][i])
        if i % N_MIXERS == 0:
            y, hr, hi = s5_mixer(h, s5_re[j], s5_im[j], p['s5_a_re'][j], p['s5_a_im'][j], p['s5_log_dt'][j],
                                 p['s5_b_re'][j], p['s5_b_im'][j], p['s5_c_re'][j], p['s5_c_im'][j],
                                 p['s5_d'][j], p['s5_w_glu'][j])
            new_re.append(hr)
            new_im.append(hi)
        else:
            y, sn = hgrn2_mixer(h, hg_s[j], lower_bounds[i], p['hg_w_in'][j], p['hg_norm'][j], p['hg_w_out'][j])
            new_hg.append(sn)
        x = x + y
        x = x + cross_attend(rmsnorm(x, p['xattn_norm'][i]), mem_k[i], mem_v[i], p['xattn_w_q'][i], p['xattn_w_o'][i])
        x = x + 0.5 * swiglu(rmsnorm(x, p['ffn2_norm'][i]), p['ffn2_w_in'][i], p['ffn2_w_out'][i])
    x = rmsnorm(x, p['final_norm'])
    return x, jnp.stack(new_re), jnp.stack(new_im), jnp.stack(new_hg)


def setup_inputs(seed: int = 0) -> dict:
    key = jax.random.key(seed)
    ks = iter(jax.random.split(key, 48))
    f32 = jnp.float32

    def nrm(shape, scale):
        return jax.random.normal(next(ks), shape, f32) * scale

    def gain(shape):
        return 1.0 + 0.05 * jax.random.normal(next(ks), shape, f32)

    G, P, GC = S5_GROUPS, S5_STATE, S5_GROUP
    n_idx = jnp.arange(P, dtype=f32)
    return {
        "x_prompt": nrm((BATCH, SEQ, D_MODEL), 1.0),
        "x_sample": nrm((DEC_BATCH, DEC_SEQ, D_MODEL), 1.0),
        "mem_prompt": nrm((BATCH, N_MEM, D_MODEL), 1.0),
        "state_s5_re": nrm((N_S5, DEC_BATCH, G, P), 0.1),
        "state_s5_im": nrm((N_S5, DEC_BATCH, G, P), 0.1),
        "state_hgrn": nrm((N_HG, DEC_BATCH, HG_HEADS, HG_DK, HG_DV), 0.3),
        "cache_mem_k": nrm((DEPTH, DEC_BATCH, N_MEM, MEM_HEADS, MEM_HD), 1.0),
        "cache_mem_v": nrm((DEPTH, DEC_BATCH, N_MEM, MEM_HEADS, MEM_HD), 1.0),
        "ffn1_norm": gain((DEPTH, D_MODEL)),
        "ffn1_w_in": nrm((DEPTH, D_MODEL, 2 * FFN_DIM), D_MODEL ** -0.5),
        "ffn1_w_out": nrm((DEPTH, FFN_DIM, D_MODEL), FFN_DIM ** -0.5),
        "mix_norm": gain((DEPTH, D_MODEL)),
        "xattn_norm": gain((DEPTH, D_MODEL)),
        "mem_norm": gain((DEPTH, D_MODEL)),
        "xattn_w_q": nrm((DEPTH, D_MODEL, D_MODEL), D_MODEL ** -0.5),
        "xattn_w_kv": nrm((DEPTH, D_MODEL, 2 * D_MODEL), D_MODEL ** -0.5),
        "xattn_w_o": nrm((DEPTH, D_MODEL, D_MODEL), D_MODEL ** -0.5),
        "ffn2_norm": gain((DEPTH, D_MODEL)),
        "ffn2_w_in": nrm((DEPTH, D_MODEL, 2 * FFN_DIM), D_MODEL ** -0.5),
        "ffn2_w_out": nrm((DEPTH, FFN_DIM, D_MODEL), FFN_DIM ** -0.5),
        "s5_a_re": -0.5 + nrm((N_S5, G, P), 0.01),
        "s5_a_im": jnp.pi * n_idx + nrm((N_S5, G, P), 0.01),
        "s5_log_dt": jax.random.uniform(next(ks), (N_S5, G), f32, math.log(S5_DT_MIN), math.log(S5_DT_MAX)),
        "s5_b_re": nrm((N_S5, G, P, GC), (2 * GC) ** -0.5),
        "s5_b_im": nrm((N_S5, G, P, GC), (2 * GC) ** -0.5),
        "s5_c_re": nrm((N_S5, G, GC, P), 2 ** -0.5),
        "s5_c_im": nrm((N_S5, G, GC, P), 2 ** -0.5),
        "s5_d": nrm((N_S5, G, GC), 1.0),
        "s5_w_glu": nrm((N_S5, D_MODEL, 2 * D_MODEL), D_MODEL ** -0.5),
        "hg_w_in": nrm((N_HG, D_MODEL, 2 * HG_WIDTH + 2 * HG_HEADS * HG_DV), D_MODEL ** -0.5),
        "hg_lb_logits": nrm((DEPTH, HG_WIDTH), 0.5),
        "hg_norm": gain((N_HG, HG_DV)),
        "hg_w_out": nrm((N_HG, HG_HEADS * HG_DV, D_MODEL), D_MODEL ** -0.5),
        "final_norm": gain((D_MODEL,)),
    }


def reference(x_prompt, x_sample, mem_prompt, state_s5_re, state_s5_im, state_hgrn, cache_mem_k, cache_mem_v,
              ffn1_norm, ffn1_w_in, ffn1_w_out, mix_norm, xattn_norm, mem_norm, xattn_w_q, xattn_w_kv, xattn_w_o,
              ffn2_norm, ffn2_w_in, ffn2_w_out, s5_a_re, s5_a_im, s5_log_dt, s5_b_re, s5_b_im, s5_c_re, s5_c_im,
              s5_d, s5_w_glu, hg_w_in, hg_lb_logits, hg_norm, hg_w_out, final_norm):
    p = dict(ffn1_norm=ffn1_norm, ffn1_w_in=ffn1_w_in, ffn1_w_out=ffn1_w_out, mix_norm=mix_norm,
             xattn_norm=xattn_norm, xattn_w_q=xattn_w_q, xattn_w_o=xattn_w_o, ffn2_norm=ffn2_norm,
             ffn2_w_in=ffn2_w_in, ffn2_w_out=ffn2_w_out, s5_a_re=s5_a_re, s5_a_im=s5_a_im, s5_log_dt=s5_log_dt,
             s5_b_re=s5_b_re, s5_b_im=s5_b_im, s5_c_re=s5_c_re, s5_c_im=s5_c_im, s5_d=s5_d, s5_w_glu=s5_w_glu,
             hg_w_in=hg_w_in, hg_norm=hg_norm, hg_w_out=hg_w_out, final_norm=final_norm)
    sm = jax.nn.softmax(hg_lb_logits.astype(jnp.float32), axis=0)
    lower_bounds = jnp.cumsum(sm, axis=0) - sm[0]

    bp = x_prompt.shape[0]
    z_re = jnp.zeros((N_S5, bp, S5_GROUPS, S5_STATE), state_s5_re.dtype)
    z_hg = jnp.zeros((N_HG, bp, HG_HEADS, HG_DK, HG_DV), state_hgrn.dtype)
    kv = [mem_kv(mem_prompt, mem_norm[i], xattn_w_kv[i]) for i in range(DEPTH)]
    mem_k_p = jnp.stack([a for a, _ in kv])
    mem_v_p = jnp.stack([b for _, b in kv])
    y_prompt, s5_re_p, s5_im_p, hg_p = trunk(x_prompt, z_re, z_re, z_hg, mem_k_p, mem_v_p, lower_bounds, p)

    y_sample, s5_re_s, s5_im_s, hg_s = trunk(x_sample, state_s5_re, state_s5_im, state_hgrn,
                                             cache_mem_k, cache_mem_v, lower_bounds, p)
    return (y_prompt, y_sample, s5_re_p, s5_im_p, s5_re_s, s5_im_s, hg_p, hg_s, mem_k_p, mem_v_p)
```

```cpp
#include <hip/hip_runtime.h>
#include <cstdio>
#include <cstdint>
namespace gold {
constexpr int D = 1024, NB = 8, T = 2048, MP = NB * T, MS = 128, R = MP + MS, FF = 2816, NMEM = 256, MROWS = NB * NMEM;
constexpr float EPS = 1e-6f;

__device__ __forceinline__ double d_exp(double x) {
    const double LN2 = 0.6931471805599453094172321, ILN2 = 1.4426950408889634073599247;
    double n = __builtin_rint(x * ILN2);
    double r = x - n * LN2;
    double s = 1.0, term = 1.0;
#pragma unroll
    for (int i = 1; i <= 16; ++i) { term *= r / (double)i; s += term; }
    long long e = (long long)n + 1023;
    double sc = __builtin_bit_cast(double, (unsigned long long)e << 52);
    return s * sc;
}
__device__ __forceinline__ void d_sincos(double th, double& sn, double& cs) {
    const double HPI = 1.5707963267948966192313217, IHPI = 0.63661977236758134307553505;
    double q = __builtin_rint(th * IHPI);
    double r = th - q * HPI;
    double r2 = r * r;
    double s = 0.0, c = 0.0;
    double ts = r, tc = 1.0; s = ts; c = tc;
#pragma unroll
    for (int i = 1; i <= 9; ++i) { tc *= -r2 / (double)((2 * i - 1) * (2 * i)); c += tc; ts *= -r2 / (double)((2 * i) * (2 * i + 1)); s += ts; }
    int qi = ((int)q) & 3;
    if (qi == 0) { sn = s; cs = c; } else if (qi == 1) { sn = c; cs = -s; } else if (qi == 2) { sn = -s; cs = -c; } else { sn = -c; cs = s; }
}

__global__ void __launch_bounds__(256) k_copy_x(const float* __restrict__ xp, const float* __restrict__ xs, float* __restrict__ X) {
    size_t n = (size_t)R * D / 4, np = (size_t)MP * D / 4;
    for (size_t i = (size_t)blockIdx.x * 256 + threadIdx.x; i < n; i += (size_t)gridDim.x * 256) {
        float4 v = i < np ? ((const float4*)xp)[i] : ((const float4*)xs)[i - np];
        ((float4*)X)[i] = v;
    }
}
__global__ void __launch_bounds__(256) k_rmsnorm(const float* __restrict__ x, const float* __restrict__ g, float* __restrict__ out, int rows) {
    int row = blockIdx.x * 4 + (threadIdx.x >> 6), lane = threadIdx.x & 63;
    if (row >= rows) return;
    const float4* xr = (const float4*)(x + (size_t)row * D);
    float4 v[4]; float s = 0.f;
#pragma unroll
    for (int j = 0; j < 4; ++j) { v[j] = xr[lane + 64 * j]; s += v[j].x * v[j].x + v[j].y * v[j].y + v[j].z * v[j].z + v[j].w * v[j].w; }
#pragma unroll
    for (int o = 1; o < 64; o <<= 1) s += __shfl_xor(s, o);
    float rs = 1.0f / sqrtf(s * (1.0f / D) + EPS);
#pragma unroll
    for (int j = 0; j < 4; ++j) { float4 gg = ((const float4*)g)[lane + 64 * j]; float4 o; o.x = v[j].x * rs * gg.x; o.y = v[j].y * rs * gg.y; o.z = v[j].z * rs * gg.z; o.w = v[j].w * rs * gg.w;
        ((float4*)(out + (size_t)row * D))[lane + 64 * j] = o; }
}
__global__ void __launch_bounds__(256) k_sgemm(const float* __restrict__ A, const float* __restrict__ B, float* __restrict__ C, int M, int N, int K, int lda, int ldb, int ldc) {
    __shared__ float As[16][68];
    __shared__ float Bs[16][64];
    const int tid = threadIdx.x, tx = tid & 15, ty = tid >> 4;
    const int bm = blockIdx.y * 64, bn = blockIdx.x * 64;
    float acc[4][4];
#pragma unroll
    for (int i = 0; i < 4; ++i)
#pragma unroll
        for (int j = 0; j < 4; ++j) acc[i][j] = 0.f;
    for (int k0 = 0; k0 < K; k0 += 16) {
        float4 a = *(const float4*)&A[(size_t)(bm + (tid >> 2)) * lda + k0 + (tid & 3) * 4];
        As[(tid & 3) * 4 + 0][tid >> 2] = a.x; As[(tid & 3) * 4 + 1][tid >> 2] = a.y; As[(tid & 3) * 4 + 2][tid >> 2] = a.z; As[(tid & 3) * 4 + 3][tid >> 2] = a.w;
        float4 b = *(const float4*)&B[(size_t)(k0 + (tid >> 4)) * ldb + bn + (tid & 15) * 4];
        *(float4*)&Bs[tid >> 4][(tid & 15) * 4] = b;
        __syncthreads();
#pragma unroll
        for (int kk = 0; kk < 16; ++kk) {
            float4 av = *(const float4*)&As[kk][ty * 4];
            float4 bv = *(const float4*)&Bs[kk][tx * 4];
            float a4[4] = {av.x, av.y, av.z, av.w}, b4[4] = {bv.x, bv.y, bv.z, bv.w};
#pragma unroll
            for (int i = 0; i < 4; ++i)
#pragma unroll
                for (int j = 0; j < 4; ++j) acc[i][j] += a4[i] * b4[j];
        }
        __syncthreads();
    }
#pragma unroll
    for (int i = 0; i < 4; ++i) { float4 o = {acc[i][0], acc[i][1], acc[i][2], acc[i][3]}; *(float4*)&C[(size_t)(bm + ty * 4 + i) * ldc + bn + tx * 4] = o; }
}
__device__ __forceinline__ float siluf(float x) { return x / (1.0f + expf(-x)); }
__device__ __forceinline__ float sigmf(float x) { return 1.0f / (1.0f + expf(-x)); }
__global__ void __launch_bounds__(256) k_swiglu(const float* __restrict__ G, float* __restrict__ Hh, int rows) {
    size_t n = (size_t)rows * FF;
    for (size_t i = (size_t)blockIdx.x * 256 + threadIdx.x; i < n; i += (size_t)gridDim.x * 256) {
        size_t r = i / FF, j = i % FF; float g = G[r * (2 * FF) + j], u = G[r * (2 * FF) + FF + j]; Hh[i] = siluf(g) * u; }
}
__global__ void __launch_bounds__(256) k_axpy(float* __restrict__ X, const float* __restrict__ Y, float sc, size_t n) {
    for (size_t i = (size_t)blockIdx.x * 256 + threadIdx.x; i < n; i += (size_t)gridDim.x * 256) X[i] += sc * Y[i];
}
__global__ void __launch_bounds__(256) k_glu_add(float* __restrict__ X, const float* __restrict__ P, int rows) {
    size_t n = (size_t)rows * D;
    for (size_t i = (size_t)blockIdx.x * 256 + threadIdx.x; i < n; i += (size_t)gridDim.x * 256) {
        size_t r = i / D, j = i % D; X[i] += P[r * 2 * D + j] * sigmf(P[r * 2 * D + D + j]); }
}
__device__ __forceinline__ float gelu_tanh(float y) { float z = 0.7978845608028654f * (y + 0.044715f * y * y * y); return 0.5f * y * (1.0f + tanhf(z)); }

__global__ void __launch_bounds__(64) k_s5(const float* __restrict__ N, float* __restrict__ Yg, int row0, int row_stride_seq, int Tlen,
                                          const float* __restrict__ h0re, const float* __restrict__ h0im, float* __restrict__ hre_out, float* __restrict__ him_out,
                                          const float* __restrict__ a_re, const float* __restrict__ a_im, const float* __restrict__ log_dt,
                                          const float* __restrict__ b_re, const float* __restrict__ b_im, const float* __restrict__ c_re, const float* __restrict__ c_im, const float* __restrict__ dd) {
    const int seq = blockIdx.x >> 6, g = blockIdx.x & 63, p = threadIdx.x;
    const double dt = d_exp((double)log_dt[g]);
    const double lr = (double)a_re[g * 64 + p], li = (double)a_im[g * 64 + p];
    double sn, cs; d_sincos(li * dt, sn, cs); const double er = d_exp(lr * dt);
    const double lbr = er * cs, lbi = er * sn;
    const double nr = lbr - 1.0, ni = lbi, den = lr * lr + li * li;
    const double fr = (nr * lr + ni * li) / den, fi = (ni * lr - nr * li) / den;
    float bbr[16], bbi[16], ccr[16], cci[16], dv[16];
#pragma unroll
    for (int c = 0; c < 16; ++c) { double br = b_re[(g * 64 + p) * 16 + c], bi = b_im[(g * 64 + p) * 16 + c]; bbr[c] = (float)(fr * br - fi * bi); bbi[c] = (float)(fr * bi + fi * br);
        ccr[c] = c_re[(g * 16 + c) * 64 + p]; cci[c] = c_im[(g * 16 + c) * 64 + p]; dv[c] = dd[g * 16 + c]; }
    const float lamr = (float)lbr, lami = (float)lbi;
    float hr = h0re ? h0re[(seq * 64 + g) * 64 + p] : 0.f, hi = h0im ? h0im[(seq * 64 + g) * 64 + p] : 0.f;
    for (int t = 0; t < Tlen; ++t) {
        const size_t row = (size_t)row0 + (size_t)seq * row_stride_seq + t;
        float u[16];
#pragma unroll
        for (int c = 0; c < 16; ++c) u[c] = N[row * D + g * 16 + c];
        float bur = 0.f, bui = 0.f;
#pragma unroll
        for (int c = 0; c < 16; ++c) { bur += u[c] * bbr[c]; bui += u[c] * bbi[c]; }
        const float nhr = lamr * hr - lami * hi + bur, nhi = lamr * hi + lami * hr + bui; hr = nhr; hi = nhi;
        float myy = 0.f;
#pragma unroll
        for (int c = 0; c < 16; ++c) { float y = hr * ccr[c] - hi * cci[c];
#pragma unroll
            for (int o = 1; o < 64; o <<= 1) y += __shfl_xor(y, o);
            y += dv[c] * u[c]; if (p == c) myy = y; }
        if (p < 16) Yg[row * D + g * 16 + p] = gelu_tanh(myy);
    }
    hre_out[(seq * 64 + g) * 64 + p] = hr; him_out[(seq * 64 + g) * 64 + p] = hi;
}
__global__ void __launch_bounds__(256) k_hgrn(const float* __restrict__ P, float* __restrict__ OG, int row0, int row_stride_seq, int Tlen,
                                            const float* __restrict__ S0, float* __restrict__ Sout, const float* __restrict__ lbv, const float* __restrict__ ng) {
    __shared__ float f_s[128], k_s[128], q_s[128], o_s[2][128], red[4];
    const int seq = blockIdx.x >> 3, h = blockIdx.x & 7, tid = threadIdx.x, v = tid & 127, kh = tid >> 7;
    float S[64];
#pragma unroll
    for (int i = 0; i < 64; ++i) S[i] = S0 ? S0[(((size_t)seq * 8 + h) * 128 + kh * 64 + i) * 128 + v] : 0.f;
    for (int t = 0; t < Tlen; ++t) {
        const size_t row = (size_t)row0 + (size_t)seq * row_stride_seq + t;
        const float* pr = P + row * 4096;
        if (tid < 128) { const int k = tid; float z = pr[1024 + h * 128 + k], lb = lbv[h * 128 + k]; float kk = (1.0f - lb) / (1.0f + expf(z)); f_s[k] = 1.0f - kk; k_s[k] = kk; q_s[k] = siluf(pr[h * 128 + k]); }
        __syncthreads();
        const float vv = pr[2048 + h * 128 + v];
        float o = 0.f;
#pragma unroll
        for (int i = 0; i < 64; ++i) { const int k = kh * 64 + i; S[i] = f_s[k] * S[i] + k_s[k] * vv; o += S[i] * q_s[k]; }
        o_s[kh][v] = o;
        __syncthreads();
        float ot = 0.f, sq = 0.f;
        if (tid < 128) { ot = o_s[0][v] + o_s[1][v]; sq = ot * ot; }
#pragma unroll
        for (int of = 1; of < 64; of <<= 1) sq += __shfl_xor(sq, of);
        if ((tid & 63) == 0) red[tid >> 6] = sq;
        __syncthreads();
        if (tid < 128) { const float ms = (red[0] + red[1]) * (1.0f / 128.0f); const float gate = siluf(pr[3072 + h * 128 + v]);
            OG[row * D + h * 128 + v] = ot * (1.0f / sqrtf(ms + EPS)) * ng[v] * gate; }
        __syncthreads();
    }
#pragma unroll
    for (int i = 0; i < 64; ++i) Sout[(((size_t)seq * 8 + h) * 128 + kh * 64 + i) * 128 + v] = S[i];
}
__global__ void __launch_bounds__(256) k_attn(const float* __restrict__ Q, float* __restrict__ O, const float* __restrict__ Kp, const float* __restrict__ Vp, const float* __restrict__ Kc, const float* __restrict__ Vc) {
    __shared__ float q_s[256], p_s[256], red[8];
    const int row = blockIdx.x >> 2, h = blockIdx.x & 3, tid = threadIdx.x;
    const float* Kb = row < MP ? Kp + (size_t)(row / T) * NMEM * D : Kc + (size_t)(row - MP) * NMEM * D;
    const float* Vb = row < MP ? Vp + (size_t)(row / T) * NMEM * D : Vc + (size_t)(row - MP) * NMEM * D;
    q_s[tid] = Q[(size_t)row * D + h * 256 + tid];
    __syncthreads();
    float s = 0.f; const float4* kr = (const float4*)(Kb + (size_t)tid * D + h * 256);
#pragma unroll 8
    for (int d = 0; d < 64; ++d) { float4 k4 = kr[d]; s += q_s[4 * d] * k4.x + q_s[4 * d + 1] * k4.y + q_s[4 * d + 2] * k4.z + q_s[4 * d + 3] * k4.w; }
    s *= 0.0625f;
    float m = s;
#pragma unroll
    for (int o = 1; o < 64; o <<= 1) m = fmaxf(m, __shfl_xor(m, o));
    if ((tid & 63) == 0) red[tid >> 6] = m;
    __syncthreads();
    m = fmaxf(fmaxf(red[0], red[1]), fmaxf(red[2], red[3]));
    float e = expf(s - m), sm = e;
#pragma unroll
    for (int o = 1; o < 64; o <<= 1) sm += __shfl_xor(sm, o);
    if ((tid & 63) == 0) red[4 + (tid >> 6)] = sm;
    p_s[tid] = e;
    __syncthreads();
    const float inv = 1.0f / (red[4] + red[5] + red[6] + red[7]);
    float o = 0.f;
#pragma unroll 8
    for (int mm = 0; mm < 256; ++mm) o += p_s[mm] * Vb[(size_t)mm * D + h * 256 + tid];
    O[(size_t)row * D + h * 256 + tid] = o * inv;
}
__global__ void __launch_bounds__(256) k_lb(const float* __restrict__ logits, float* __restrict__ lb) {
    int i = blockIdx.x * 256 + threadIdx.x; if (i < 1024) lb[i] = 1.0f / (1.0f + expf(-(logits[1024 + i] - logits[i])));
}

__global__ void __launch_bounds__(256) k_split_kv(const float* __restrict__ kv, float* __restrict__ k, float* __restrict__ v) {
    size_t n = (size_t)MROWS * D;
    for (size_t i = (size_t)blockIdx.x * 256 + threadIdx.x; i < n; i += (size_t)gridDim.x * 256) { size_t r = i / D, j = i % D; k[i] = kv[r * 2 * D + j]; v[i] = kv[r * 2 * D + D + j]; }
}
struct Bufs { float *X, *Nn, *G, *Hh, *Y, *lb; };
static inline void sgemm(hipStream_t st, const float* A, const float* B, float* C, int M, int N, int K) {
    k_sgemm<<<dim3(N / 64, M / 64), 256, 0, st>>>(A, B, C, M, N, K, K, N, N);
}
static void forward(void* const* d_in, float* out, float* wsf, hipStream_t st) {
    auto in = [&](int i) { return (const float*)d_in[i]; };
    float* X = wsf;
    float* Nn = X + (size_t)R * D;
    float* G = Nn + (size_t)R * D;
    float* Hh = G + (size_t)R * 2 * FF;
    float* Y = Hh + (size_t)R * FF;
    float* lb = Y + (size_t)R * D;
    float* memn = lb + 1024;
    float* kvt = memn + (size_t)MROWS * D;
    float* o_y = out; float* o_s5re_p = out + (size_t)R * D; float* o_s5im_p = o_s5re_p + 32768; float* o_s5re_s = o_s5im_p + 32768; float* o_s5im_s = o_s5re_s + 524288;
    float* o_hg_p = o_s5im_s + 524288; float* o_hg_s = o_hg_p + 1048576; float* o_mk = o_hg_s + 16777216; float* o_mv = o_mk + 4194304;
    k_copy_x<<<2048, 256, 0, st>>>(in(0), in(1), X);
    k_lb<<<4, 256, 0, st>>>(in(30), lb);
    for (int l = 0; l < 2; ++l) {
        k_rmsnorm<<<MROWS / 4, 256, 0, st>>>(in(2), in(13) + l * D, memn, MROWS);
        sgemm(st, memn, in(15) + (size_t)l * D * 2 * D, kvt, MROWS, 2 * D, D);
        k_split_kv<<<2048, 256, 0, st>>>(kvt, o_mk + (size_t)l * MROWS * D, o_mv + (size_t)l * MROWS * D);
    }
    for (int l = 0; l < 2; ++l) {
        k_rmsnorm<<<R / 4, 256, 0, st>>>(X, in(8) + l * D, Nn, R);
        sgemm(st, Nn, in(9) + (size_t)l * D * 2 * FF, G, R, 2 * FF, D);
        k_swiglu<<<4096, 256, 0, st>>>(G, Hh, R);
        sgemm(st, Hh, in(10) + (size_t)l * FF * D, Y, R, D, FF);
        k_axpy<<<4096, 256, 0, st>>>(X, Y, 0.5f, (size_t)R * D);
        k_rmsnorm<<<R / 4, 256, 0, st>>>(X, in(11) + l * D, Nn, R);
        if (l == 0) {
            k_s5<<<NB * 64, 64, 0, st>>>(Nn, Y, 0, T, T, nullptr, nullptr, o_s5re_p, o_s5im_p, in(20), in(21), in(22), in(23), in(24), in(25), in(26), in(27));
            k_s5<<<MS * 64, 64, 0, st>>>(Nn, Y, MP, 1, 1, in(3), in(4), o_s5re_s, o_s5im_s, in(20), in(21), in(22), in(23), in(24), in(25), in(26), in(27));
            sgemm(st, Y, in(28), G, R, 2 * D, D);
            k_glu_add<<<4096, 256, 0, st>>>(X, G, R);
        } else {
            sgemm(st, Nn, in(29), G, R, 4 * D, D);
            k_hgrn<<<NB * 8, 256, 0, st>>>(G, Y, 0, T, T, nullptr, o_hg_p, lb, in(31));
            k_hgrn<<<MS * 8, 256, 0, st>>>(G, Y, MP, 1, 1, in(5), o_hg_s, lb, in(31));
            sgemm(st, Y, in(32), Hh, R, D, D);
            k_axpy<<<4096, 256, 0, st>>>(X, Hh, 1.0f, (size_t)R * D);
        }
        k_rmsnorm<<<R / 4, 256, 0, st>>>(X, in(12) + l * D, Nn, R);
        sgemm(st, Nn, in(14) + (size_t)l * D * D, Y, R, D, D);
        k_attn<<<R * 4, 256, 0, st>>>(Y, Hh, o_mk + (size_t)l * MROWS * D, o_mv + (size_t)l * MROWS * D, in(6) + (size_t)l * MS * NMEM * D, in(7) + (size_t)l * MS * NMEM * D);
        sgemm(st, Hh, in(16) + (size_t)l * D * D, Y, R, D, D);
        k_axpy<<<4096, 256, 0, st>>>(X, Y, 1.0f, (size_t)R * D);
        k_rmsnorm<<<R / 4, 256, 0, st>>>(X, in(17) + l * D, Nn, R);
        sgemm(st, Nn, in(18) + (size_t)l * D * 2 * FF, G, R, 2 * FF, D);
        k_swiglu<<<4096, 256, 0, st>>>(G, Hh, R);
        sgemm(st, Hh, in(19) + (size_t)l * FF * D, Y, R, D, FF);
        k_axpy<<<4096, 256, 0, st>>>(X, Y, 0.5f, (size_t)R * D);
    }
    k_rmsnorm<<<R / 4, 256, 0, st>>>(X, in(33), o_y, R);
}
}
extern "C" void kernel_launch(void* const* d_in, const int* in_sizes, int n_in, void* d_out, int out_size, void* d_ws, size_t ws_size, hipStream_t stream) {
    if (n_in != 34 || out_size != 44236800 || ws_size < (size_t)900 * 1024 * 1024) { fprintf(stderr, "kernel_launch: unexpected sizes n_in=%d out=%d ws=%zu\n", n_in, out_size, ws_size); return; }
    gold::forward(d_in, (float*)d_out, (float*)d_ws, stream);
}
```

```cpp
#include <hip/hip_runtime.h>
#include <cstdio>
#include <cstdint>
#include <cmath>
namespace gold {
__device__ __forceinline__ double d_exp(double x) {
    const double LN2 = 0.6931471805599453094172321, ILN2 = 1.4426950408889634073599247;
    double n = __builtin_rint(x * ILN2);
    double r = x - n * LN2;
    double s = 1.0, term = 1.0;
#pragma unroll
    for (int i = 1; i <= 16; ++i) { term *= r / (double)i; s += term; }
    long long e = (long long)n + 1023;
    double sc = __builtin_bit_cast(double, (unsigned long long)e << 52);
    return s * sc;
}
__device__ __forceinline__ void d_sincos(double th, double& sn, double& cs) {
    const double HPI = 1.5707963267948966192313217, IHPI = 0.63661977236758134307553505;
    double q = __builtin_rint(th * IHPI);
    double r = th - q * HPI;
    double r2 = r * r;
    double s = 0.0, c = 0.0;
    double ts = r, tc = 1.0; s = ts; c = tc;
#pragma unroll
    for (int i = 1; i <= 9; ++i) { tc *= -r2 / (double)((2 * i - 1) * (2 * i)); c += tc; ts *= -r2 / (double)((2 * i) * (2 * i + 1)); s += ts; }
    int qi = ((int)q) & 3;
    if (qi == 0) { sn = s; cs = c; } else if (qi == 1) { sn = c; cs = -s; } else if (qi == 2) { sn = -s; cs = -c; } else { sn = -c; cs = s; }
}
}
namespace pg8 {
#define PG8_LAS __attribute__((address_space(3)))
typedef unsigned short bf16_t;
typedef short bf16x8 __attribute__((ext_vector_type(8)));
typedef float f32x4 __attribute__((ext_vector_type(4)));
typedef unsigned u32x4 __attribute__((ext_vector_type(4)));
constexpr int BM = 256, BK = 64, HALF = 128, HTB = HALF * BK * 2  , STAGE_BYTES = 8 * HTB, NXCD = 8, WGM = 8;

__host__ __device__ __forceinline__ int lds_byte(int r, int c) { const int st = (r >> 4) * 2 + (c >> 5), rr = r & 15, cc = c & 31, ob = rr * 64 + cc * 2; return st * 1024 + (ob ^ (((ob >> 9) & 1) << 5)); }
__host__ __device__ __forceinline__ void stage_rc(int b, int& R, int& C) { const int st = b / 1024, sb = b % 1024, swz = sb ^ (((sb >> 9) & 1) << 5); R = (st >> 1) * 16 + swz / 64; C = (st & 1) * 32 + (swz % 64) / 2; }
__host__ __device__ __forceinline__ int perm32(int rho) { const int n = rho >> 4, i = rho & 15; return 8 * (i >> 2) + 4 * n + (i & 3); }

struct Unit { int pm, pn; };
struct Gemm { const bf16_t* A; const bf16_t* Bt; int M, N, K; };

struct StaticOrder {
    int nM, nN, nwg, G, c;
    __host__ __device__ void init(int M, int N, int G_, int c_) { nM = M / BM; nN = N / BM; nwg = nM * nN; G = G_; c = c_; }
    __host__ __device__ bool next(int i, Unit& u) const {
        const long L = (long)i * G + c; if (L >= nwg) return false;
        int wgid = (int)L; { const int q = nwg / NXCD, r = nwg % NXCD, xcd = wgid % NXCD, off = wgid / NXCD; wgid = (xcd < r ? xcd * (q + 1) : r * (q + 1) + (xcd - r) * q) + off; }
        const int nig = WGM * nN, gid = wgid / nig, fm = gid * WGM, gsz = (nM - fm) < WGM ? (nM - fm) : WGM;
        u.pm = fm + ((wgid % nig) % gsz); u.pn = (wgid % nig) / gsz; return true;
    }
    __device__ __forceinline__ void a_ready(const Unit&) const {}
    __device__ __forceinline__ void done(const Unit&) const {}
};

__device__ __forceinline__ unsigned cvt_pk_bf16(float lo, float hi) { unsigned r; asm volatile("v_cvt_pk_bf16_f32 %0, %1, %2" : "=v"(r) : "v"(lo), "v"(hi)); return r; }
typedef float f32x2 __attribute__((ext_vector_type(2)));
template <class Epi, class Sched, bool ALIGN_EPI = false, bool SP2 = false>
__device__ __forceinline__ void gemm_phase(PG8_LAS unsigned char* lds, const Gemm g, const Sched& S, const Epi& E, const int tid_in) {
    const int tid = tid_in, wid = __builtin_amdgcn_readfirstlane(tid >> 6), lane = tid & 63, wr = wid >> 2, wc = wid & 3, fr = lane & 15, fq = lane >> 4;
    const int K = g.K, nt = K / BK;
    unsigned voffA[2], voffB[2];
#pragma unroll
    for (int i = 0; i < 2; ++i) { int R, C; stage_rc(tid * 16 + i * 8192, R, C); const int Rb = Epi::PERM ? ((R & ~31) + perm32(R & 31)) : R;
        voffA[i] = (unsigned)(R * K + C) * 2u; voffB[i] = (unsigned)(Rb * K + C) * 2u; }
    const size_t kstep = (size_t)(BK * 2);
    const size_t hstep = (size_t)HALF * K * 2;
    const size_t tstep = 2 * hstep;
    const unsigned ldsw = (unsigned)wid * 1024u;
    const int aoff = lds_byte(wr * 64 + fr, fq * 8), boff = lds_byte(wc * 32 + fr, fq * 8);
#define PG8_SA(b, h) (((b) * 2 + (h)) * HTB)
#define PG8_SB(b, h) ((4 + (b) * 2 + (h)) * HTB)
#define PG8_STAGE(bufoff, gbase, voff) do { _Pragma("unroll") for (int _i = 0; _i < 2; ++_i) \
        __builtin_amdgcn_global_load_lds((const unsigned*)((const char*)(gbase) + (voff)[_i]), (PG8_LAS unsigned*)(lds + (bufoff) + ldsw + _i * 8192), 16, 0, 0); } while (0)
#define PG8_LDA(dst, b, h) do { _Pragma("unroll") for (int m = 0; m < 4; ++m) _Pragma("unroll") for (int k = 0; k < 2; ++k) dst[m][k] = *(const PG8_LAS bf16x8*)(lds + PG8_SA(b, h) + aoff + m * 2048 + k * 1024); } while (0)
#define PG8_LDB(dst, b, h) do { _Pragma("unroll") for (int n = 0; n < 2; ++n) _Pragma("unroll") for (int k = 0; k < 2; ++k) dst[n][k] = *(const PG8_LAS bf16x8*)(lds + PG8_SB(b, h) + boff + n * 2048 + k * 1024); } while (0)
#define PG8_MMA(ai, bj, At, Bt) do { __builtin_amdgcn_s_setprio(1); _Pragma("unroll") for (int m = 0; m < 4; ++m) _Pragma("unroll") for (int n = 0; n < 2; ++n) _Pragma("unroll") for (int k = 0; k < 2; ++k) \
        acc[ai][bj][m][n] = __builtin_amdgcn_mfma_f32_16x16x32_bf16(Bt[n][k], At[m][k], acc[ai][bj][m][n], 0, 0, 0); __builtin_amdgcn_s_setprio(0); } while (0)
#define PG8_WAIT_V(n) asm volatile("s_waitcnt vmcnt(" #n ")" ::: "memory")
#define PG8_WAIT_L(n) asm volatile("s_waitcnt lgkmcnt(" #n ")" ::: "memory")
#define PG8_BAR __builtin_amdgcn_s_barrier()
#define PG8_SCHED __builtin_amdgcn_sched_barrier(0)
    Unit cur, nxt; int ui = 0;
    if (!S.next(0, cur)) return;
    f32x4 acc[2][2][4][2];
#pragma unroll
    for (int a = 0; a < 2; ++a)
#pragma unroll
        for (int b = 0; b < 2; ++b)
#pragma unroll
            for (int m = 0; m < 4; ++m)
#pragma unroll
                for (int n = 0; n < 2; ++n) acc[a][b][m][n] = (f32x4){0.f, 0.f, 0.f, 0.f};
    bf16x8 At[4][2], B0[2][2], B1[2][2];
    const char* cA = (const char*)g.A + (size_t)cur.pm * tstep; const char* cB = (const char*)g.Bt + (size_t)cur.pn * tstep;
    S.a_ready(cur);
    if constexpr (SP2) {
        PG8_STAGE(PG8_SB(0, 0), cB, voffB); PG8_STAGE(PG8_SB(0, 1), cB + hstep, voffB); PG8_STAGE(PG8_SA(0, 0), cA, voffA); PG8_STAGE(PG8_SA(0, 1), cA + hstep, voffA);
        if (wr == 1) PG8_BAR;
        PG8_WAIT_V(2); PG8_BAR;
        PG8_STAGE(PG8_SB(1, 0), cB + kstep, voffB); PG8_STAGE(PG8_SA(1, 0), cA + kstep, voffA); PG8_STAGE(PG8_SB(1, 1), cB + hstep + kstep, voffB);
        PG8_WAIT_V(6); PG8_BAR;
    } else {
        PG8_STAGE(PG8_SB(0, 0), cB, voffB); PG8_STAGE(PG8_SA(0, 0), cA, voffA); PG8_STAGE(PG8_SB(0, 1), cB + hstep, voffB); PG8_STAGE(PG8_SA(0, 1), cA + hstep, voffA);
        if (wr == 1) PG8_BAR;
        PG8_WAIT_V(4); PG8_BAR;
        PG8_STAGE(PG8_SB(1, 0), cB + kstep, voffB); PG8_STAGE(PG8_SA(1, 0), cA + kstep, voffA); PG8_STAGE(PG8_SB(1, 1), cB + hstep + kstep, voffB);
        PG8_WAIT_V(6); PG8_BAR;
    }
    for (;;) {
        const bool has_next = S.next(ui + 1, nxt);
        const char* nA = has_next ? (const char*)g.A + (size_t)nxt.pm * tstep : cA; const char* nB = has_next ? (const char*)g.Bt + (size_t)nxt.pn * tstep : cB;
        for (int t = 0; t < nt; t += 2) {
            const bool last = (t == nt - 2);
            const char* a1 = cA + (size_t)(t + 1) * kstep;
            const char* a2 = last ? nA : cA + (size_t)(t + 2) * kstep; const char* b2 = last ? nB : cB + (size_t)(t + 2) * kstep;
            const char* a3 = a2 + kstep; const char* b3 = b2 + kstep;
            if (last && has_next) S.a_ready(nxt);
            if constexpr (SP2) {
            PG8_LDB(B0, 0, 0); PG8_LDB(B1, 0, 1); PG8_SCHED; PG8_LDA(At, 0, 0); PG8_STAGE(PG8_SA(1, 1), a1 + hstep, voffA);
            PG8_WAIT_V(8); PG8_WAIT_L(0); PG8_BAR; PG8_MMA(0, 0, At, B0); PG8_MMA(0, 1, At, B1); PG8_BAR; PG8_SCHED;
            PG8_LDA(At, 0, 1); PG8_STAGE(PG8_SB(0, 0), b2, voffB); PG8_STAGE(PG8_SB(0, 1), b2 + hstep, voffB); PG8_STAGE(PG8_SA(0, 0), a2, voffA);
            PG8_WAIT_V(8); PG8_WAIT_L(0); PG8_BAR; PG8_MMA(1, 0, At, B0); PG8_MMA(1, 1, At, B1); PG8_BAR; PG8_SCHED;
            PG8_LDB(B0, 1, 0); PG8_LDB(B1, 1, 1); PG8_SCHED; PG8_LDA(At, 1, 0); PG8_STAGE(PG8_SA(0, 1), a2 + hstep, voffA);
            PG8_WAIT_V(8); PG8_WAIT_L(0); PG8_BAR; PG8_MMA(0, 0, At, B0); PG8_MMA(0, 1, At, B1); PG8_BAR; PG8_SCHED;
            PG8_LDA(At, 1, 1); PG8_STAGE(PG8_SB(1, 0), b3, voffB); PG8_STAGE(PG8_SB(1, 1), b3 + hstep, voffB); PG8_STAGE(PG8_SA(1, 0), a3, voffA);
            PG8_WAIT_V(8); PG8_WAIT_L(0); PG8_BAR; PG8_MMA(1, 0, At, B0); PG8_MMA(1, 1, At, B1); PG8_BAR; PG8_SCHED;
            } else {
            PG8_LDB(B0, 0, 0); PG8_SCHED; PG8_LDA(At, 0, 0); PG8_STAGE(PG8_SA(1, 1), a1 + hstep, voffA);
            PG8_WAIT_L(8); PG8_BAR; PG8_WAIT_L(0); PG8_MMA(0, 0, At, B0); PG8_BAR; PG8_SCHED;
            PG8_LDB(B1, 0, 1); PG8_STAGE(PG8_SB(0, 0), b2, voffB);
            PG8_BAR; PG8_WAIT_L(0); PG8_MMA(0, 1, At, B1); PG8_BAR;
            PG8_LDA(At, 0, 1); PG8_STAGE(PG8_SA(0, 0), a2, voffA);
            PG8_BAR; PG8_WAIT_L(0); PG8_MMA(1, 0, At, B0); PG8_BAR; PG8_SCHED;
            PG8_STAGE(PG8_SB(0, 1), b2 + hstep, voffB);
            PG8_WAIT_V(6); PG8_BAR; PG8_MMA(1, 1, At, B1); PG8_BAR;
            PG8_LDB(B0, 1, 0); PG8_SCHED; PG8_LDA(At, 1, 0); PG8_STAGE(PG8_SA(0, 1), a2 + hstep, voffA);
            PG8_WAIT_L(8); PG8_BAR; PG8_WAIT_L(0); PG8_MMA(0, 0, At, B0); PG8_BAR; PG8_SCHED;
            PG8_LDB(B1, 1, 1); PG8_STAGE(PG8_SB(1, 0), b3, voffB);
            PG8_BAR; PG8_WAIT_L(0); PG8_MMA(0, 1, At, B1); PG8_BAR;
            PG8_LDA(At, 1, 1); PG8_STAGE(PG8_SA(1, 0), a3, voffA);
            PG8_BAR; PG8_WAIT_L(0); PG8_MMA(1, 0, At, B0); PG8_BAR; PG8_SCHED;
            PG8_STAGE(PG8_SB(1, 1), b3 + hstep, voffB);
            PG8_WAIT_V(6); PG8_BAR; PG8_MMA(1, 1, At, B1); PG8_BAR;
            }
        }
        if constexpr (ALIGN_EPI) { if (wr == 0) PG8_BAR; }
        if constexpr (!Epi::AFTER_DRAIN) { E(acc, cur, wr, wc, fr, fq); S.done(cur); }
        if (!has_next) break;
#pragma unroll
        for (int a = 0; a < 2; ++a)
#pragma unroll
            for (int b = 0; b < 2; ++b)
#pragma unroll
                for (int m = 0; m < 4; ++m)
#pragma unroll
                    for (int n = 0; n < 2; ++n) acc[a][b][m][n] = (f32x4){0.f, 0.f, 0.f, 0.f};
        cur = nxt; cA = nA; cB = nB; ++ui;
        if constexpr (ALIGN_EPI) { if (wr == 1) PG8_BAR; }
    }
    PG8_WAIT_V(0);
    if constexpr (!ALIGN_EPI) { if (wr == 0) PG8_BAR; }
    PG8_BAR;
    if constexpr (Epi::AFTER_DRAIN) { E.fused(acc, cur, wr, wc, fr, fq, lds, wid, lane); S.done(cur); }
#undef PG8_SA
#undef PG8_SB
#undef PG8_STAGE
#undef PG8_LDA
#undef PG8_LDB
#undef PG8_MMA
#undef PG8_WAIT_V
#undef PG8_WAIT_L
#undef PG8_BAR
#undef PG8_SCHED
}
}
#define GAS __attribute__((address_space(1)))
#define LAS __attribute__((address_space(3)))
typedef unsigned short bf16;
typedef unsigned v4u __attribute__((ext_vector_type(4)));
typedef float f32x4 __attribute__((ext_vector_type(4)));
typedef short bf16x8 __attribute__((ext_vector_type(8)));
typedef GAS unsigned gu32;
typedef GAS unsigned long long gu64;
#define RLX_AGENT __ATOMIC_RELAXED, __HIP_MEMORY_SCOPE_AGENT
#define LDS_WAIT() asm volatile("s_waitcnt lgkmcnt(0)" ::: "memory")
#define VM_WAIT() asm volatile("s_waitcnt vmcnt(0)" ::: "memory")
__device__ __forceinline__ unsigned long long rt() { return __builtin_amdgcn_s_memrealtime(); }
__device__ __forceinline__ unsigned f2bf(float f) { unsigned u = __builtin_bit_cast(unsigned, f); return (u + 0x7fffu + ((u >> 16) & 1u)) >> 16; }
__device__ __forceinline__ unsigned pk2(float lo, float hi) { return f2bf(lo) | (f2bf(hi) << 16); }
#define XB_TMO      128
#define XB_XCNT(j)  (256  + 64 * (j))
#define XB_XSUB(j)  (1280 + 64 * (j))
#define XB_XGEN(j)  (2304 + 64 * (j))
#define XB_TOP      3328
#define XB_TOPGEN   3392
#define XCD_BAR_WORDS 3456
#define XB_SPIN_CAP (1u << 18)

__device__ __forceinline__ unsigned xb_ld(unsigned* p)              { return __hip_atomic_load(p, __ATOMIC_RELAXED, __HIP_MEMORY_SCOPE_AGENT); }
__device__ __forceinline__ unsigned xb_add(unsigned* p, unsigned v) { return __hip_atomic_fetch_add(p, v, __ATOMIC_RELAXED, __HIP_MEMORY_SCOPE_AGENT); }
__device__ __forceinline__ unsigned xb_xcc_id() { return (unsigned)__builtin_amdgcn_s_getreg((3 << 11) | 20) & 0xFu; }
#define XB_SPIN(cond, bar) do { unsigned _sp = 0; while (cond) { __builtin_amdgcn_s_sleep(1); \
    if ((++_sp & 255u) == 0u) { if (xb_ld(&(bar)[XB_TMO])) break; if (_sp > XB_SPIN_CAP) { atomicAdd(&(bar)[XB_TMO], 1u); break; } } } } while (0)

struct XcdBarrier {
    unsigned* bar; unsigned x;
    volatile LAS unsigned* st;
};

__device__ __forceinline__ XcdBarrier xcd_barrier_post(unsigned* bar, volatile LAS unsigned* st, bool leader) {
    XcdBarrier b; b.bar = bar; b.x = xb_xcc_id(); b.st = st;
    if (leader) (void)xb_add(&bar[XB_XCNT(b.x)], 1u);
    return b;
}
__device__ __forceinline__ void xcd_barrier_complete(unsigned* bar, unsigned x, unsigned& nloc, unsigned& nx) {
    const unsigned G = gridDim.x * gridDim.y * gridDim.z;
    unsigned sum, cnt, mine, sp = 0u;
    for (;;) {
        sum = 0u; cnt = 0u; mine = 0u;
#pragma unroll
        for (unsigned j = 0; j < 16; ++j) { const unsigned c = xb_ld(&bar[XB_XCNT(j)]); sum += c; cnt += (c > 0u) ? 1u : 0u; mine = (j == x) ? c : mine; }
        if (sum == G) break;
        __builtin_amdgcn_s_sleep(1);
        if ((++sp & 255u) == 0u) { if (xb_ld(&bar[XB_TMO])) break; if (sp > XB_SPIN_CAP) { atomicAdd(&bar[XB_TMO], 1u); break; } }
    }
    nloc = mine > 0u ? mine : 1u; nx = cnt > 0u ? cnt : 1u;
}

__device__ __forceinline__ void xcd_barrier(const XcdBarrier& b, bool leader) {
    asm volatile("s_waitcnt vmcnt(0)" ::: "memory");
    __syncthreads();
    if (leader) {
        unsigned* bar = b.bar;
        __builtin_amdgcn_s_waitcnt(0);
        unsigned nloc = b.st[0], nx = b.st[1];
        if (nloc == 0u) { xcd_barrier_complete(bar, b.x, nloc, nx); b.st[0] = nloc; b.st[1] = nx; }
        const unsigned old = xb_add(&bar[XB_XSUB(b.x)], 1u);
        const unsigned gen = old / nloc;
        if (old + 1u == (gen + 1u) * nloc) {
            __builtin_amdgcn_fence(__ATOMIC_RELEASE, "agent");
            asm volatile("s_waitcnt vmcnt(0)" ::: "memory");
            const unsigned og = xb_add(&bar[XB_TOP], 1u);
            const unsigned tg = og / nx;
            if (og + 1u == (tg + 1u) * nx) xb_add(&bar[XB_TOPGEN], 1u);
            else XB_SPIN(xb_ld(&bar[XB_TOPGEN]) == tg, bar);
            __builtin_amdgcn_fence(__ATOMIC_ACQUIRE, "agent");
            xb_add(&bar[XB_XGEN(b.x)], 1u);
            asm volatile("s_waitcnt vmcnt(0)" ::: "memory");
        } else {
            XB_SPIN(xb_ld(&bar[XB_XGEN(b.x)]) == gen, bar);
            __builtin_amdgcn_fence(__ATOMIC_ACQUIRE, "agent");
            asm volatile("s_waitcnt vmcnt(0)" ::: "memory");
        }
    }
    __syncthreads();
}
namespace fk {
using pg8::bf16_t; using pg8::f32x4; using pg8::bf16x8; using pg8::u32x4; using pg8::Unit; using pg8::cvt_pk_bf16;
typedef float f32x16 __attribute__((ext_vector_type(16)));
typedef unsigned u32x2 __attribute__((ext_vector_type(2)));
typedef float f32x2 __attribute__((ext_vector_type(2)));
#define FLAS __attribute__((address_space(3)))

constexpr int D = 1024, NB = 8, T = 2048, MP = 16384, MS = 128, R = 16512, MT = 16640, FF = 2816, NMEM = 256;
constexpr float EPS = 1e-6f;
constexpr float QSCALE = 0.0625f * 1.4426950408889634f;
constexpr int NWAVES = 8, NTHR = 512;
constexpr int S5L = 128, S5NC = T / S5L;

constexpr size_t MiB = 1u << 20;
constexpr size_t WS_CTL = 0, CTL_ZERO_BYTES = 1 * MiB;
constexpr size_t WS_LAM = 1 * MiB;
constexpr size_t WS_LAMP = WS_LAM + 32768;
constexpr size_t WS_BB = WS_LAMP + 32768;
constexpr size_t WS_CP = WS_BB + 262144;
constexpr size_t WS_LB = WS_CP + 327680;
constexpr size_t WS_SSQ = 3 * MiB;
constexpr size_t WS_SSQS = WS_SSQ + (size_t)MT * 32 * 4;
constexpr size_t WS_E = 6 * MiB;
constexpr size_t WS_BT = 10 * MiB;
constexpr size_t WS_DBG = 11 * MiB;
constexpr size_t WS_W1IN = 12 * MiB, W1IN_SZ = (size_t)2 * FF * D * 2;
constexpr size_t WS_W1OUT = 34 * MiB, W1OUT_SZ = (size_t)D * FF * 2;
constexpr size_t WS_W2IN = 45 * MiB, WS_W2OUT = 67 * MiB;
constexpr size_t WS_WQ = 78 * MiB, WS_WO = 82 * MiB, WQ_SZ = (size_t)D * D * 2;
constexpr size_t WS_WKV = 86 * MiB, WS_WGLU = 94 * MiB, WS_WHGIN = 98 * MiB, WS_WHGOUT = 106 * MiB;
constexpr size_t WS_MEMN = 108 * MiB, WS_KBM = 112 * MiB, WS_VTM = 120 * MiB;
constexpr size_t WS_X = 128 * MiB, WS_XB = 193 * MiB, WS_AB = 226 * MiB, WS_QB = 259 * MiB, WS_GH = 292 * MiB;
constexpr size_t WS_VT = 325 * MiB  , WS_LOGF = 358 * MiB, WS_SST = 423 * MiB, WS_HB = 487 * MiB, WS_SLOC = 487 * MiB;
constexpr size_t WS_FAST_END = 615 * MiB;
static_assert(WS_W1IN + 2 * W1IN_SZ <= WS_W1OUT && WS_W1OUT + 2 * W1OUT_SZ <= WS_W2IN && WS_W2IN + 2 * W1IN_SZ <= WS_W2OUT && WS_W2OUT + 2 * W1OUT_SZ <= WS_WQ, "ws map");
static_assert(WS_X + (size_t)MT * D * 4 <= WS_XB && WS_XB + (size_t)MT * D * 2 <= WS_AB && WS_HB + (size_t)MT * FF * 2 <= WS_FAST_END && WS_SLOC + (size_t)2048 * 16384 * 4 <= WS_FAST_END, "ws map 2");
static_assert(WS_LOGF + (size_t)MT * D * 4 <= WS_SST && WS_SST + (size_t)2048 * 16384 * 2 <= WS_HB && WS_SSQS + 128 * 64 * 4 <= WS_E, "ws map 3");
constexpr size_t O_Y = 0, O_S5RE_P = (size_t)R * D, O_S5IM_P = O_S5RE_P + 32768, O_S5RE_S = O_S5IM_P + 32768, O_S5IM_S = O_S5RE_S + 524288,
                 O_HG_P = O_S5IM_S + 524288, O_HG_S = O_HG_P + 1048576, O_MK = O_HG_S + 16777216, O_MV = O_MK + 4194304, O_END = O_MV + 4194304;
static_assert(O_END == 44236800, "out size");

constexpr int RING_BYTES = 131072, LDSCTL_OFF = RING_BYTES, MISC_OFF = LDSCTL_OFF + 320, LDS_BYTES = 147456;

__device__ __forceinline__ float fast_exp(float x) { return __builtin_amdgcn_exp2f(x * 1.4426950408889634f); }
__device__ __forceinline__ float fast_rcp(float x) { return __builtin_amdgcn_rcpf(x); }
__device__ __forceinline__ float silu_f(float x) { return x * fast_rcp(1.0f + fast_exp(-x)); }
__device__ __forceinline__ float sigm_f(float x) { return fast_rcp(1.0f + fast_exp(-x)); }
__device__ __forceinline__ unsigned f2bf(float f) { unsigned u = __builtin_bit_cast(unsigned, f); return (u + 0x7fffu + ((u >> 16) & 1u)) >> 16; }
__device__ __forceinline__ unsigned pk2(float lo, float hi) { return cvt_pk_bf16(lo, hi); }
__device__ __forceinline__ float bf2f(unsigned short b) { return __builtin_bit_cast(float, (unsigned)b << 16); }
__device__ __forceinline__ float bflo(unsigned w) { return __builtin_bit_cast(float, w << 16); }
__device__ __forceinline__ float bfhi(unsigned w) { return __builtin_bit_cast(float, w & 0xffff0000u); }
__device__ __forceinline__ float wave_sum(float v) {
#pragma unroll
    for (int o = 1; o < 64; o <<= 1) v += __shfl_xor(v, o);
    return v;
}
typedef _Float16 h16x2 __attribute__((ext_vector_type(2)));
__device__ __forceinline__ unsigned pkh2(float lo, float hi) { const h16x2 v = {(_Float16)lo, (_Float16)hi}; return __builtin_bit_cast(unsigned, v); }
__device__ __forceinline__ float hlo(unsigned w) { return (float)__builtin_bit_cast(h16x2, w)[0]; }
__device__ __forceinline__ float hhi(unsigned w) { return (float)__builtin_bit_cast(h16x2, w)[1]; }
template <int NP> __device__ __forceinline__ float row_rstd(const float* __restrict__ ssq, int row) {
    const f32x4* p = (const f32x4*)(ssq + (size_t)row * 32); float s = 0.f;
#pragma unroll
    for (int i = 0; i < NP / 4; ++i) { const f32x4 v = p[i]; s += (v[0] + v[1]) + (v[2] + v[3]); }
    return 1.0f / sqrtf(s * (1.0f / D) + EPS);
}

template <int NP> __device__ __forceinline__ void tile_rstd8(const float* __restrict__ ssq, int pm, int wr, int fr, int fq, float (&rs)[2][4]) {
    f32x4 p[2][4][NP / 16];
#pragma unroll
    for (int ai = 0; ai < 2; ++ai)
#pragma unroll
        for (int m = 0; m < 4; ++m)
#pragma unroll
            for (int j = 0; j < NP / 16; ++j) p[ai][m][j] = *(const f32x4*)(ssq + (size_t)(pm * 256 + ai * 128 + wr * 64 + m * 16 + fr) * 32 + 4 * fq + 16 * j);
    __builtin_amdgcn_sched_barrier(0);
#pragma unroll
    for (int ai = 0; ai < 2; ++ai)
#pragma unroll
        for (int m = 0; m < 4; ++m) { float a = 0.f;
#pragma unroll
            for (int j = 0; j < NP / 16; ++j) a += (p[ai][m][j][0] + p[ai][m][j][1]) + (p[ai][m][j][2] + p[ai][m][j][3]);
            a += __shfl_xor(a, 16); a += __shfl_xor(a, 32);
            rs[ai][m] = 1.0f / sqrtf(a * (1.0f / D) + EPS); }
}
#define EPI_ROWS_BEGIN  _Pragma("unroll") for (int ai = 0; ai < 2; ++ai) _Pragma("unroll") for (int m = 0; m < 4; ++m) { const int row = u.pm * 256 + ai * 128 + wr * 64 + m * 16 + fr;
#define EPI_ROWS_END    }

template <int NP> struct EpiSwiglu {
    static constexpr bool PERM = true, AFTER_DRAIN = false;
    const float* ssq; bf16_t* H;
    __device__ __forceinline__ void operator()(const f32x4 (&acc)[2][2][4][2], const Unit& u, int wr, int wc, int fr, int fq) const {
        const int col0 = u.pn * 128 + wc * 32 + 8 * fq;
        float rsv[2][4]; tile_rstd8<NP>(ssq, u.pm, wr, fr, fq, rsv);
        EPI_ROWS_BEGIN
            const float rs = rsv[ai][m];
            float h[8];
#pragma unroll
            for (int n = 0; n < 2; ++n)
#pragma unroll
                for (int i = 0; i < 4; ++i) { const float g = acc[ai][0][m][n][i] * rs, up = acc[ai][1][m][n][i] * rs; h[4 * n + i] = silu_f(g) * up; }
            u32x4 w; w.x = pk2(h[0], h[1]); w.y = pk2(h[2], h[3]); w.z = pk2(h[4], h[5]); w.w = pk2(h[6], h[7]);
            *(u32x4*)(H + (size_t)row * FF + col0) = w;
        EPI_ROWS_END
    }
};
__device__ __forceinline__ void bf8_to_f32(const u32x4 w, f32x4& lo, f32x4& hi) { lo = (f32x4){bflo(w.x), bfhi(w.x), bflo(w.y), bfhi(w.y)}; hi = (f32x4){bflo(w.z), bfhi(w.z), bflo(w.w), bfhi(w.w)}; }
struct EpiResid {
    static constexpr bool PERM = true, AFTER_DRAIN = false;
    bf16_t* XB; float* ssq; float scale;
    __device__ __forceinline__ void operator()(const f32x4 (&acc)[2][2][4][2], const Unit& u, int wr, int wc, int fr, int fq) const {
#pragma unroll
        for (int ai = 0; ai < 2; ++ai) {
            u32x4 xv[4][2];
#pragma unroll
            for (int m = 0; m < 4; ++m)
#pragma unroll
                for (int bj = 0; bj < 2; ++bj) xv[m][bj] = *(const u32x4*)(XB + (size_t)(u.pm * 256 + ai * 128 + wr * 64 + m * 16 + fr) * D + u.pn * 256 + bj * 128 + wc * 32 + 8 * fq);
            __builtin_amdgcn_sched_barrier(0);
#pragma unroll
            for (int m = 0; m < 4; ++m) { const int row = u.pm * 256 + ai * 128 + wr * 64 + m * 16 + fr;
                float sq = 0.f;
#pragma unroll
                for (int bj = 0; bj < 2; ++bj) {
                    const size_t off = (size_t)row * D + u.pn * 256 + bj * 128 + wc * 32 + 8 * fq;
                    f32x4 x0, x1; bf8_to_f32(xv[m][bj], x0, x1);
                    x0 = x0 + acc[ai][bj][m][0] * scale; x1 = x1 + acc[ai][bj][m][1] * scale;
                    u32x4 w; w.x = pk2(x0[0], x0[1]); w.y = pk2(x0[2], x0[3]); w.z = pk2(x1[0], x1[1]); w.w = pk2(x1[2], x1[3]);
                    *(u32x4*)(XB + off) = w;
                    bf8_to_f32(w, x0, x1);
                    sq += (x0[0] * x0[0] + x0[1] * x0[1]) + (x0[2] * x0[2] + x0[3] * x0[3]) + (x1[0] * x1[0] + x1[1] * x1[1]) + (x1[2] * x1[2] + x1[3] * x1[3]);
                }
                sq += __shfl_xor(sq, 16); sq += __shfl_xor(sq, 32);
                if (fq == 0) ssq[(size_t)row * 32 + u.pn * 4 + wc] = sq; }
            __builtin_amdgcn_sched_barrier(0);
        }
    }
};
struct EpiGlu {
    static constexpr bool PERM = true, AFTER_DRAIN = false;
    bf16_t* XB; float* ssq;
    __device__ __forceinline__ void operator()(const f32x4 (&acc)[2][2][4][2], const Unit& u, int wr, int wc, int fr, int fq) const {
        u32x4 xv[2][4];
#pragma unroll
        for (int ai = 0; ai < 2; ++ai)
#pragma unroll
            for (int m = 0; m < 4; ++m) xv[ai][m] = *(const u32x4*)(XB + (size_t)(u.pm * 256 + ai * 128 + wr * 64 + m * 16 + fr) * D + u.pn * 128 + wc * 32 + 8 * fq);
        __builtin_amdgcn_sched_barrier(0);
        EPI_ROWS_BEGIN
            const size_t off = (size_t)row * D + u.pn * 128 + wc * 32 + 8 * fq;
            f32x4 x0, x1; bf8_to_f32(xv[ai][m], x0, x1);
#pragma unroll
            for (int i = 0; i < 4; ++i) { x0[i] += acc[ai][0][m][0][i] * sigm_f(acc[ai][1][m][0][i]); x1[i] += acc[ai][0][m][1][i] * sigm_f(acc[ai][1][m][1][i]); }
            u32x4 w; w.x = pk2(x0[0], x0[1]); w.y = pk2(x0[2], x0[3]); w.z = pk2(x1[0], x1[1]); w.w = pk2(x1[2], x1[3]);
            *(u32x4*)(XB + off) = w;
            bf8_to_f32(w, x0, x1);
            float sq = (x0[0] * x0[0] + x0[1] * x0[1]) + (x0[2] * x0[2] + x0[3] * x0[3]) + (x1[0] * x1[0] + x1[1] * x1[1]) + (x1[2] * x1[2] + x1[3] * x1[3]);
            sq += __shfl_xor(sq, 16); sq += __shfl_xor(sq, 32);
            if (fq == 0) ssq[(size_t)row * 32 + u.pn * 4 + wc] = sq;
        EPI_ROWS_END
    }
};
template <int NP> struct EpiQ {
    static constexpr bool PERM = true, AFTER_DRAIN = false;
    const float* ssq; bf16_t* Q;
    __device__ __forceinline__ void operator()(const f32x4 (&acc)[2][2][4][2], const Unit& u, int wr, int wc, int fr, int fq) const {
        float rsv[2][4]; tile_rstd8<NP>(ssq, u.pm, wr, fr, fq, rsv);
        EPI_ROWS_BEGIN
            const float rs = rsv[ai][m] * QSCALE;
#pragma unroll
            for (int bj = 0; bj < 2; ++bj) {
                const size_t off = (size_t)row * D + u.pn * 256 + bj * 128 + wc * 32 + 8 * fq;
                const f32x4 a = acc[ai][bj][m][0] * rs, b = acc[ai][bj][m][1] * rs;
                u32x4 w; w.x = pk2(a[0], a[1]); w.y = pk2(a[2], a[3]); w.z = pk2(b[0], b[1]); w.w = pk2(b[2], b[3]);
                *(u32x4*)(Q + off) = w;
            }
        EPI_ROWS_END
    }
};
__device__ __forceinline__ int perm16pos(int m) { return (m & ~12) | ((m & 4) << 1) | ((m & 8) >> 1); }
struct EpiMemKV {
    static constexpr bool PERM = true, AFTER_DRAIN = false;
    float* out; bf16_t* KB; bf16_t* VT;
    __device__ __forceinline__ void operator()(const f32x4 (&acc)[2][2][4][2], const Unit& u, int wr, int wc, int fr, int fq) const {
        const int layer = u.pn >> 3, kv = (u.pn >> 2) & 1, jt = (u.pn & 3) * 256;
        EPI_ROWS_BEGIN
#pragma unroll
            for (int bj = 0; bj < 2; ++bj) {
                const int j = jt + bj * 128 + wc * 32 + 8 * fq;
                const f32x4 a = acc[ai][bj][m][0], b = acc[ai][bj][m][1];
                float* o = out + (kv ? O_MV : O_MK) + ((size_t)layer * 2048 + row) * D + j;
                *(f32x4*)o = a; *(f32x4*)(o + 4) = b;
                if (kv == 0) { u32x4 w; w.x = pk2(a[0], a[1]); w.y = pk2(a[2], a[3]); w.z = pk2(b[0], b[1]); w.w = pk2(b[2], b[3]);
                    *(u32x4*)(KB + ((size_t)layer * 2048 + row) * D + j) = w; }
                else {
                    const int bb = row >> 8, mm = row & 255, hh = j >> 8, dv = j & 255;
                    bf16_t* vt = VT + ((((size_t)layer * 8 + bb) * 4 + hh) * 256 + dv) * 256 + perm16pos(mm);
#pragma unroll
                    for (int i = 0; i < 4; ++i) { vt[(size_t)i * 256] = (bf16_t)f2bf(a[i]); vt[(size_t)(4 + i) * 256] = (bf16_t)f2bf(b[i]); }
                }
            }
        EPI_ROWS_END
    }
};
template <int NP> struct EpiHgIn {
    static constexpr bool PERM = true, AFTER_DRAIN = false;
    const float* ssq; const float* lb; bf16_t* QH; unsigned short* LOGF  ; bf16_t* VN; bf16_t* GH;
    __device__ __forceinline__ void operator()(const f32x4 (&acc)[2][2][4][2], const Unit& u, int wr, int wc, int fr, int fq) const {
        const int sec = u.pn >> 2, jt = (u.pn & 3) * 256;
        float rsv[2][4]; tile_rstd8<NP>(ssq, u.pm, wr, fr, fq, rsv);
        EPI_ROWS_BEGIN
            const float rs = rsv[ai][m];
#pragma unroll
            for (int bj = 0; bj < 2; ++bj) {
                const int j = jt + bj * 128 + wc * 32 + 8 * fq;
                const f32x4 a = acc[ai][bj][m][0] * rs, b = acc[ai][bj][m][1] * rs;
                if (sec == 1) {
                    const f32x4 l0 = *(const f32x4*)(lb + j), l1 = *(const f32x4*)(lb + j + 4);
                    f32x4 o0, o1;
#pragma unroll
                    for (int i = 0; i < 4; ++i) { const float k0 = (1.0f - l0[i]) * fast_rcp(1.0f + fast_exp(a[i])), k1 = (1.0f - l1[i]) * fast_rcp(1.0f + fast_exp(b[i]));
                        o0[i] = __builtin_amdgcn_logf(1.0f - k0) * 0.6931471805599453f; o1[i] = __builtin_amdgcn_logf(1.0f - k1) * 0.6931471805599453f; }
                    u32x4 w; w.x = pkh2(o0[0], o0[1]); w.y = pkh2(o0[2], o0[3]); w.z = pkh2(o1[0], o1[1]); w.w = pkh2(o1[2], o1[3]);
                    *(u32x4*)(LOGF + (size_t)row * D + j) = w;
                } else {
                    float s[8];
#pragma unroll
                    for (int i = 0; i < 4; ++i) { s[i] = sec == 2 ? a[i] : silu_f(a[i]); s[4 + i] = sec == 2 ? b[i] : silu_f(b[i]); }
                    u32x4 w; w.x = pk2(s[0], s[1]); w.y = pk2(s[2], s[3]); w.z = pk2(s[4], s[5]); w.w = pk2(s[6], s[7]);
                    const size_t off = (size_t)row * D + j;
                    if (sec == 0) *(u32x4*)(QH + off) = w; else if (sec == 2) *(u32x4*)(VN + off) = w; else *(u32x4*)(GH + off) = w;
                }
            }
        EPI_ROWS_END
    }
};

__device__ __forceinline__ float srow_rstd(const float* __restrict__ ssqs, int srow) {
    const f32x4* p = (const f32x4*)(ssqs + (size_t)srow * 64); float s = 0.f;
#pragma unroll
    for (int i = 0; i < 16; ++i) { const f32x4 v = p[i]; s += (v[0] + v[1]) + (v[2] + v[3]); }
    return 1.0f / sqrtf(s * (1.0f / D) + EPS);
}
__device__ __forceinline__ void srow_rstd4(const float* __restrict__ ssqs, int srow0, int cl, float (&rs)[4]) {
#pragma unroll
    for (int j = 0; j < 4; ++j) { const f32x4 v = *(const f32x4*)(ssqs + (size_t)(srow0 + j) * 64 + 4 * cl); float s = (v[0] + v[1]) + (v[2] + v[3]);
        s += __shfl_xor(s, 1); s += __shfl_xor(s, 2); s += __shfl_xor(s, 4); s += __shfl_xor(s, 8); rs[j] = 1.0f / sqrtf(s * (1.0f / D) + EPS); }
}
template <bool PAIRED, int KS, int NT, class SEpi>
__device__ __forceinline__ void skinny_unit(const bf16_t* __restrict__ A, const bf16_t* __restrict__ Bt, int u, int wave, int lane, FLAS unsigned char* lds, const SEpi& E) {
    constexpr int K = KS * 128, NB_ = PAIRED ? 2 : 1, NACC = NT * NB_, CH = (KS == 8) ? ((NACC >= 4) ? 4 : 8) : 11, NCH = KS / CH;
    static_assert(KS % CH == 0, "chunking");
    const int cl = lane & 15, kq = lane >> 4, rt = wave & 1, kw = wave >> 1, rb = u & 3, uc = u >> 2;
    const int srow = 32 * rb + 16 * rt;
    const bf16_t* ap = A + (size_t)(MP + srow + cl) * K + kw * (KS * 32) + 8 * kq;
    const bf16_t* bp[NACC];
#pragma unroll
    for (int t = 0; t < NT; ++t) { const int c = 16 * (NT * uc + t) + cl;
        if (PAIRED) { const int rw = (c >> 7) * 256 + (c & 127); bp[2 * t] = Bt + (size_t)rw * K + kw * (KS * 32) + 8 * kq; bp[2 * t + 1] = bp[2 * t] + (size_t)128 * K; }
        else bp[t] = Bt + (size_t)c * K + kw * (KS * 32) + 8 * kq; }
    f32x4 acc[NACC];
#pragma unroll
    for (int i = 0; i < NACC; ++i) acc[i] = (f32x4){0.f, 0.f, 0.f, 0.f};
#pragma unroll
    for (int chn = 0; chn < NCH; ++chn) {
        bf16x8 a[CH], b[NACC][CH];
#pragma unroll
        for (int i = 0; i < CH; ++i) { a[i] = *(const bf16x8*)(ap + 32 * (chn * CH + i));
#pragma unroll
            for (int j = 0; j < NACC; ++j) b[j][i] = *(const bf16x8*)(bp[j] + 32 * (chn * CH + i)); }
        __builtin_amdgcn_sched_barrier(0);
#pragma unroll
        for (int i = 0; i < CH; ++i)
#pragma unroll
            for (int j = 0; j < NACC; ++j) acc[j] = __builtin_amdgcn_mfma_f32_16x16x32_bf16(a[i], b[j][i], acc[j], 0, 0, 0);
        __builtin_amdgcn_sched_barrier(0);
    }
    FLAS f32x4* red = (FLAS f32x4*)lds;
#pragma unroll
    for (int j = 0; j < NACC; ++j) red[(wave * NACC + j) * 64 + lane] = acc[j];
    asm volatile("s_waitcnt lgkmcnt(0)" ::: "memory"); __builtin_amdgcn_s_barrier(); asm volatile("" ::: "memory");
    if (kw == 0) {
#pragma unroll
        for (int q = 1; q < 4; ++q)
#pragma unroll
            for (int j = 0; j < NACC; ++j) acc[j] = acc[j] + red[((rt + 2 * q) * NACC + j) * 64 + lane];
#pragma unroll
        for (int t = 0; t < NT; ++t) { const f32x4 pr[2] = {acc[NB_ * t], acc[NB_ * t + (NB_ - 1)]}; E(pr, srow + 4 * kq, 16 * (NT * uc + t) + cl, NT * uc + t, cl); }
    }
    asm volatile("s_waitcnt lgkmcnt(0)" ::: "memory"); __builtin_amdgcn_s_barrier(); asm volatile("" ::: "memory");
}
struct SEpiSwiglu { const float* ssqs; bf16_t* H;
    __device__ __forceinline__ void operator()(const f32x4 (&acc)[2], int srow0, int col, int, int cl) const {
        float rs[4]; srow_rstd4(ssqs, srow0, cl, rs);
#pragma unroll
        for (int j = 0; j < 4; ++j) H[(size_t)(MP + srow0 + j) * FF + col] = (bf16_t)f2bf(silu_f(acc[0][j] * rs[j]) * (acc[1][j] * rs[j])); } };
struct SEpiResid { bf16_t* XB; float* ssqs; float scale;
    __device__ __forceinline__ void operator()(const f32x4 (&acc)[2], int srow0, int col, int u, int cl) const {
#pragma unroll
        for (int j = 0; j < 4; ++j) { const size_t off = (size_t)(MP + srow0 + j) * D + col; const unsigned short xb_ = (unsigned short)f2bf(bf2f(XB[off]) + scale * acc[0][j]); XB[off] = xb_; const float x = bf2f(xb_); float sq = x * x;
            sq += __shfl_xor(sq, 1); sq += __shfl_xor(sq, 2); sq += __shfl_xor(sq, 4); sq += __shfl_xor(sq, 8);
            if (cl == 0) ssqs[(size_t)(srow0 + j) * 64 + u] = sq; } } };
struct SEpiGlu { bf16_t* XB; float* ssqs;
    __device__ __forceinline__ void operator()(const f32x4 (&acc)[2], int srow0, int col, int u, int cl) const {
#pragma unroll
        for (int j = 0; j < 4; ++j) { const size_t off = (size_t)(MP + srow0 + j) * D + col; const unsigned short xb_ = (unsigned short)f2bf(bf2f(XB[off]) + acc[0][j] * sigm_f(acc[1][j])); XB[off] = xb_; const float x = bf2f(xb_); float sq = x * x;
            sq += __shfl_xor(sq, 1); sq += __shfl_xor(sq, 2); sq += __shfl_xor(sq, 4); sq += __shfl_xor(sq, 8);
            if (cl == 0) ssqs[(size_t)(srow0 + j) * 64 + u] = sq; } } };
struct SEpiQ { const float* ssqs; bf16_t* Q;
    __device__ __forceinline__ void operator()(const f32x4 (&acc)[2], int srow0, int col, int, int cl) const {
        float rs[4]; srow_rstd4(ssqs, srow0, cl, rs);
#pragma unroll
        for (int j = 0; j < 4; ++j) Q[(size_t)(MP + srow0 + j) * D + col] = (bf16_t)f2bf(acc[0][j] * rs[j] * QSCALE); } };
struct SEpiHgIn { const float* ssqs; const float* lb; bf16_t* QH; unsigned short* LOGF  ; bf16_t* VN; bf16_t* GH;
    __device__ __forceinline__ void operator()(const f32x4 (&acc)[2], int srow0, int col, int u, int cl) const {
        const int sec = u >> 6, c = col & 1023;
        float rs[4]; srow_rstd4(ssqs, srow0, cl, rs);
#pragma unroll
        for (int j = 0; j < 4; ++j) { const size_t off = (size_t)(MP + srow0 + j) * D + c; const float v = acc[0][j] * rs[j];
            if (sec == 0) QH[off] = (bf16_t)f2bf(silu_f(v));
            else if (sec == 1) { const float kk = (1.0f - lb[c]) * fast_rcp(1.0f + fast_exp(v)); LOGF[off] = __builtin_bit_cast(unsigned short, (_Float16)(__builtin_amdgcn_logf(1.0f - kk) * 0.6931471805599453f)); }
            else if (sec == 2) VN[off] = (bf16_t)f2bf(v);
            else GH[off] = (bf16_t)f2bf(silu_f(v)); } } };
struct Args { const float* in[34]; float* out; unsigned char* ws; int ph_lo, ph_hi; };
#define KAS __attribute__((address_space(4)))
struct Frame {
    FLAS unsigned char* lds;
    int tid, lane, wave, vcu, G;
    KAS const char* ka; float* out; unsigned char* ws;
};
static_assert(sizeof(Args) == 296, "Args layout");
#define FIN(i) (*(const float* KAS const*)(F.ka + 8 * (i)))
#define WSP(T_, off) ((T_*)(F.ws + (off)))

__device__ __forceinline__ void prep_transpose_item(const float* __restrict__ W, int K, int N, bf16_t* __restrict__ WT, int mode, int row_off_or_S, const float* __restrict__ gain,
                                                    FLAS float* scr, int item, int lane) {
    const int nblk = N / 32, kb = item / nblk, nb = item % nblk, k0 = 64 * kb, n0 = 32 * nb;
    {   f32x4 v[8]; const int r8 = lane >> 3, c4 = 4 * (lane & 7);
#pragma unroll
        for (int i = 0; i < 8; ++i) v[i] = *(const f32x4*)(W + (size_t)(k0 + 8 * i + r8) * N + n0 + c4);
        __builtin_amdgcn_sched_barrier(0);
#pragma unroll
        for (int i = 0; i < 8; ++i) { const int kk = 8 * i + r8; const float g = gain ? gain[k0 + kk] : 1.0f;
            scr[kk * 33 + c4] = v[i][0] * g; scr[kk * 33 + c4 + 1] = v[i][1] * g; scr[kk * 33 + c4 + 2] = v[i][2] * g; scr[kk * 33 + c4 + 3] = v[i][3] * g; } }
    asm volatile("s_waitcnt lgkmcnt(0)" ::: "memory");
    int d0;
    if (mode == 0) d0 = row_off_or_S + n0;
    else { const int S = row_off_or_S; if (n0 < S) d0 = (n0 >> 7) * 256 + (n0 & 127); else { const int j = n0 - S; d0 = (j >> 7) * 256 + 128 + (j & 127); } }
    const int c = lane & 7;
#pragma unroll
    for (int j = 0; j < 4; ++j) { const int n = (lane >> 3) + 8 * j; const FLAS float* s = scr + (8 * c) * 33 + n;
        u32x4 o; o.x = pk2(s[0 * 33], s[1 * 33]); o.y = pk2(s[2 * 33], s[3 * 33]); o.z = pk2(s[4 * 33], s[5 * 33]); o.w = pk2(s[6 * 33], s[7 * 33]);
        *(u32x4*)(WT + (size_t)(d0 + n) * K + k0 + 8 * c) = o; }
    asm volatile("s_waitcnt lgkmcnt(0)" ::: "memory");
}

__device__ __forceinline__ void phase_prep(Frame& F) {
    FLAS float* scr = (FLAS float*)(F.lds + F.wave * 16384);
    const int gw = F.vcu * NWAVES + F.wave, NGW = F.G * NWAVES, lane = F.lane;
    constexpr int I_IN = 16 * 176, I_OUT = 44 * 32, I_SQ = 16 * 32, I_KV = 16 * 64, I_GLU = 16 * 64, I_HGIN = 16 * 128;
    constexpr int NITEMS = 4 * I_IN + 4 * I_OUT + 4 * I_SQ + 2 * I_KV + I_GLU + I_HGIN + I_SQ;
    for (int it = gw; it < NITEMS; it += NGW) {
        int r = it;
        if (r < 4 * I_IN) { const int w = r / I_IN, l = w & 1, second = w >> 1; r -= w * I_IN;
            prep_transpose_item(FIN(second ? 18 : 9) + (size_t)l * D * 2 * FF, D, 2 * FF, WSP(bf16_t, (second ? WS_W2IN : WS_W1IN) + l * W1IN_SZ), 1, FF, FIN(second ? 17 : 8) + l * D, scr, r, lane); continue; }
        r -= 4 * I_IN;
        if (r < 4 * I_OUT) { const int w = r / I_OUT, l = w & 1, second = w >> 1; r -= w * I_OUT;
            prep_transpose_item(FIN(second ? 19 : 10) + (size_t)l * FF * D, FF, D, WSP(bf16_t, (second ? WS_W2OUT : WS_W1OUT) + l * W1OUT_SZ), 0, 0, nullptr, scr, r, lane); continue; }
        r -= 4 * I_OUT;
        if (r < 2 * I_SQ) { const int l = r / I_SQ; r -= l * I_SQ;
            prep_transpose_item(FIN(14) + (size_t)l * D * D, D, D, WSP(bf16_t, WS_WQ + l * WQ_SZ), 0, 0, FIN(12) + l * D, scr, r, lane); continue; }
        r -= 2 * I_SQ;
        if (r < 2 * I_SQ) { const int l = r / I_SQ; r -= l * I_SQ;
            prep_transpose_item(FIN(16) + (size_t)l * D * D, D, D, WSP(bf16_t, WS_WO + l * WQ_SZ), 0, 0, nullptr, scr, r, lane); continue; }
        r -= 2 * I_SQ;
        if (r < 2 * I_KV) { const int l = r / I_KV; r -= l * I_KV;
            prep_transpose_item(FIN(15) + (size_t)l * D * 2 * D, D, 2 * D, WSP(bf16_t, WS_WKV), 0, l * 2048, FIN(13) + l * D, scr, r, lane); continue; }
        r -= 2 * I_KV;
        if (r < I_GLU) { prep_transpose_item(FIN(28), D, 2 * D, WSP(bf16_t, WS_WGLU), 1, D, nullptr, scr, r, lane); continue; }
        r -= I_GLU;
        if (r < I_HGIN) { prep_transpose_item(FIN(29), D, 4 * D, WSP(bf16_t, WS_WHGIN), 0, 0, FIN(11) + D, scr, r, lane); continue; }
        r -= I_HGIN;
        prep_transpose_item(FIN(32), D, D, WSP(bf16_t, WS_WHGOUT), 0, 0, nullptr, scr, r, lane);
    }
    bf16_t* XB = WSP(bf16_t, WS_XB); float* SSQ = WSP(float, WS_SSQ);
    for (int row = gw; row < MT; row += NGW) {
        f32x4 v[4]; float s = 0.f;
        const float* src = row < MP ? FIN(0) + (size_t)row * D : FIN(1) + (size_t)(row - MP) * D;
#pragma unroll
        for (int j = 0; j < 4; ++j) { v[j] = row < R ? ((const f32x4*)src)[lane + 64 * j] : (f32x4){0.f, 0.f, 0.f, 0.f}; s += (v[j][0] * v[j][0] + v[j][1] * v[j][1]) + (v[j][2] * v[j][2] + v[j][3] * v[j][3]); }
        s = wave_sum(s);
#pragma unroll
        for (int j = 0; j < 4; ++j) { u32x2 w; w.x = pk2(v[j][0], v[j][1]); w.y = pk2(v[j][2], v[j][3]); ((u32x2*)(XB + (size_t)row * D))[lane + 64 * j] = w; }
        if (lane < 32) SSQ[(size_t)row * 32 + lane] = lane == 0 ? s : 0.f;
        if (row >= MP && row < R) WSP(float, WS_SSQS)[(size_t)(row - MP) * 64 + lane] = lane == 0 ? s : 0.f;
    }
    bf16_t* MEMN = WSP(bf16_t, WS_MEMN);
    for (int row = gw; row < NB * NMEM; row += NGW) {
        f32x4 v[4]; float s = 0.f;
#pragma unroll
        for (int j = 0; j < 4; ++j) { v[j] = ((const f32x4*)(FIN(2) + (size_t)row * D))[lane + 64 * j]; s += (v[j][0] * v[j][0] + v[j][1] * v[j][1]) + (v[j][2] * v[j][2] + v[j][3] * v[j][3]); }
        const float rs = 1.0f / sqrtf(wave_sum(s) * (1.0f / D) + EPS);
#pragma unroll
        for (int j = 0; j < 4; ++j) { u32x2 w; w.x = pk2(v[j][0] * rs, v[j][1] * rs); w.y = pk2(v[j][2] * rs, v[j][3] * rs); ((u32x2*)(MEMN + (size_t)row * D))[lane + 64 * j] = w; }
    }
    if (gw < 64) {
        const int g = gw, p = lane, pl = p & 31, ph = p >> 5;
        const double dt = gold::d_exp((double)FIN(22)[g]);
        const double lr = (double)FIN(20)[g * 64 + p], li = (double)FIN(21)[g * 64 + p];
        double sn, cs; gold::d_sincos(li * dt, sn, cs); const double er = gold::d_exp(lr * dt);
        const double lbr = er * cs, lbi = er * sn;
        double sn2, cs2; gold::d_sincos(li * dt * (double)S5L, sn2, cs2); const double er2 = gold::d_exp(lr * dt * (double)S5L);
        WSP(f32x2, WS_LAM)[g * 64 + p] = (f32x2){(float)lbr, (float)lbi};
        WSP(f32x2, WS_LAMP)[g * 64 + p] = (f32x2){(float)(er2 * cs2), (float)(er2 * sn2)};
        const double nr = lbr - 1.0, ni = lbi, den = lr * lr + li * li;
        const double fr = (nr * lr + ni * li) / den, fi = (ni * lr - nr * li) / den;
        bf16_t* BB = WSP(bf16_t, WS_BB); bf16_t* CP = WSP(bf16_t, WS_CP);
        const float* gain = FIN(11);
#pragma unroll
        for (int c = 0; c < 16; ++c) { const double br = FIN(23)[(g * 64 + p) * 16 + c], bi = FIN(24)[(g * 64 + p) * 16 + c], gn = gain[g * 16 + c];
            BB[((g * 4 + ph) * 32 + pl) * 16 + c] = (bf16_t)f2bf((float)((fr * br - fi * bi) * gn));
            BB[((g * 4 + 2 + ph) * 32 + pl) * 16 + c] = (bf16_t)f2bf((float)((fr * bi + fi * br) * gn));
            CP[(g * 16 + c) * 160 + 4 * pl + 2 * ph] = (bf16_t)f2bf(FIN(25)[(g * 16 + c) * 64 + p]);
            CP[(g * 16 + c) * 160 + 4 * pl + 2 * ph + 1] = (bf16_t)f2bf(-FIN(26)[(g * 16 + c) * 64 + p]); }
        if (p < 16) {
            unsigned zz = 0u; asm volatile("" : "+v"(zz));
            const unsigned dval = f2bf(FIN(27)[g * 16 + p] * gain[g * 16 + p]);
            unsigned* cpw = (unsigned*)(CP + (g * 16 + p) * 160 + 128);
#pragma unroll
            for (int c2 = 0; c2 < 16; ++c2) cpw[c2] = (c2 < 8) ? (((2 * c2 == p) ? dval : zz) | ((2 * c2 + 1 == p) ? (dval << 16) : zz)) : zz;
        }
    }
    if (gw >= 64 && gw < 80) { const int i = (gw - 64) * 64 + lane; WSP(float, WS_LB)[i] = 1.0f / (1.0f + expf(-(FIN(30)[1024 + i] - FIN(30)[i]))); }
}

constexpr int S5_RS = 336;
template <int MODE> __device__ __forceinline__ void s5_task(Frame& F, int gb, int sp) {
    const int lane = F.lane, g = gb * 8 + F.wave, col = lane & 31, hi = lane >> 5;
    const bf16_t* XBp = WSP(bf16_t, WS_XB); const float* SSQ = WSP(float, WS_SSQ);
    const bf16_t* BB = WSP(bf16_t, WS_BB); const bf16_t* CP = WSP(bf16_t, WS_CP);
    FLAS unsigned char* hl = F.lds + F.wave * (32 * S5_RS);
    bf16x8 bbf[4];
#pragma unroll
    for (int nb = 0; nb < 4; ++nb) bbf[nb] = *(const bf16x8*)(BB + ((g * 4 + nb) * 32 + col) * 16 + 8 * hi);
    const f32x2 lam0 = WSP(f32x2, WS_LAM)[g * 64 + col], lam1 = WSP(f32x2, WS_LAM)[g * 64 + 32 + col];
    const int rho = lane & 31, hr = (rho >> 2) & 1, tr = (rho & 3) + 4 * (rho >> 3);
    int rowA, rowC0, rowC1;
    int nsteps;
    if (MODE == 2) { rowC0 = MP + sp * 32; rowC1 = rowC0 + 16; nsteps = 1; }
    else { const int s0 = sp, s1 = sp + 64; rowC0 = (s0 >> 4) * T + (s0 & 15) * S5L; rowC1 = (s1 >> 4) * T + (s1 & 15) * S5L; nsteps = S5L / 16; }
    rowA = hr ? rowC1 : rowC0;
    float h0r = 0.f, h0i = 0.f, h1r = 0.f, h1i = 0.f;
    if (MODE == 1) {
        const int s = sp + 64 * hi, c = s & 15;
        const f32x2 lp0 = WSP(f32x2, WS_LAMP)[g * 64 + col], lp1 = WSP(f32x2, WS_LAMP)[g * 64 + 32 + col];
        const f32x2* E = WSP(f32x2, WS_E);
        for (int mch = 0; mch < c; ++mch) {
            const f32x2 e0 = E[((size_t)(s - c + mch) * 64 + g) * 64 + col], e1 = E[((size_t)(s - c + mch) * 64 + g) * 64 + 32 + col];
            const float a = lp0[0] * h0r - lp0[1] * h0i + e0[0], b = lp0[0] * h0i + lp0[1] * h0r + e0[1]; h0r = a; h0i = b;
            const float a1 = lp1[0] * h1r - lp1[1] * h1i + e1[0], b1 = lp1[0] * h1i + lp1[1] * h1r + e1[1]; h1r = a1; h1i = b1;
        }
    }
    bf16x8 cpf[5];
    if (MODE != 0) {
#pragma unroll
        for (int ks = 0; ks < 5; ++ks) cpf[ks] = *(const bf16x8*)(CP + (g * 16 + (lane & 15)) * 160 + 32 * ks + 8 * (lane >> 4));
    }
    for (int step = 0; step < nsteps; ++step) {
        const int arow = rowA + step * 16 + tr;
        const float rs = MODE == 2 ? srow_rstd(WSP(float, WS_SSQS), arow - MP) : row_rstd<16>(SSQ, arow);
        f32x4 u0, u1; bf8_to_f32(*(const u32x4*)(XBp + (size_t)arow * D + g * 16 + 8 * hi), u0, u1);
        u32x4 aw; aw.x = pk2(u0[0] * rs, u0[1] * rs); aw.y = pk2(u0[2] * rs, u0[3] * rs); aw.z = pk2(u1[0] * rs, u1[1] * rs); aw.w = pk2(u1[2] * rs, u1[3] * rs);
        const bf16x8 af = __builtin_bit_cast(bf16x8, aw);
        f32x16 bu[4];
#pragma unroll
        for (int nb = 0; nb < 4; ++nb) { f32x16 z = {}; bu[nb] = __builtin_amdgcn_mfma_f32_32x32x16_bf16(af, bbf[nb], z, 0, 0, 0); }
        if (MODE != 0) { asm volatile("s_waitcnt lgkmcnt(0)" ::: "memory");
            *(FLAS u32x4*)(hl + (16 * hr + tr) * S5_RS + 256 + 16 * hi) = aw; }
        const int crow0 = hi ? rowC1 : rowC0;
#pragma unroll
        for (int r = 0; r < 16; ++r) {
            if (MODE == 2) {
                const int smp = (crow0 - MP) + r;
                const float s0r = FIN(3)[((size_t)smp * 64 + g) * 64 + col], s0i = FIN(4)[((size_t)smp * 64 + g) * 64 + col];
                const float s1r = FIN(3)[((size_t)smp * 64 + g) * 64 + 32 + col], s1i = FIN(4)[((size_t)smp * 64 + g) * 64 + 32 + col];
                h0r = lam0[0] * s0r - lam0[1] * s0i + bu[0][r]; h0i = lam0[0] * s0i + lam0[1] * s0r + bu[2][r];
                h1r = lam1[0] * s1r - lam1[1] * s1i + bu[1][r]; h1i = lam1[0] * s1i + lam1[1] * s1r + bu[3][r];
                F.out[O_S5RE_S + ((size_t)smp * 64 + g) * 64 + col] = h0r; F.out[O_S5IM_S + ((size_t)smp * 64 + g) * 64 + col] = h0i;
                F.out[O_S5RE_S + ((size_t)smp * 64 + g) * 64 + 32 + col] = h1r; F.out[O_S5IM_S + ((size_t)smp * 64 + g) * 64 + 32 + col] = h1i;
            } else {
                const float a = lam0[0] * h0r - lam0[1] * h0i + bu[0][r], b = lam0[0] * h0i + lam0[1] * h0r + bu[2][r]; h0r = a; h0i = b;
                const float a1 = lam1[0] * h1r - lam1[1] * h1i + bu[1][r], b1 = lam1[0] * h1i + lam1[1] * h1r + bu[3][r]; h1r = a1; h1i = b1;
            }
            if (MODE != 0) { u32x2 w; w.x = pk2(h0r, h0i); w.y = pk2(h1r, h1i); *(FLAS u32x2*)(hl + (16 * hi + r) * S5_RS + 8 * col) = w; }
        }
        if (MODE != 0) {
            asm volatile("s_waitcnt lgkmcnt(0)" ::: "memory");
#pragma unroll
            for (int tile = 0; tile < 2; ++tile) {
                f32x4 y = {0.f, 0.f, 0.f, 0.f};
#pragma unroll
                for (int ks = 0; ks < 5; ++ks) {
                    bf16x8 a = *(const FLAS bf16x8*)(hl + (16 * tile + (lane & 15)) * S5_RS + 64 * ks + 16 * (lane >> 4));
                    if (ks == 4 && (lane >> 4) >= 2) a = (bf16x8){0, 0, 0, 0, 0, 0, 0, 0};
                    y = __builtin_amdgcn_mfma_f32_16x16x32_bf16(a, cpf[ks], y, 0, 0, 0);
                }
                bf16_t* YG = WSP(bf16_t, WS_AB);
                const int yrow = (tile ? rowC1 : rowC0) + step * 16 + 4 * (lane >> 4);
#pragma unroll
                for (int j = 0; j < 4; ++j) { const float v = y[j]; const float z = 0.7978845608028654f * (v + 0.044715f * v * v * v);
                    const float ge = v * fast_rcp(1.0f + fast_exp(-2.0f * z));
                    YG[(size_t)(yrow + j) * D + g * 16 + (lane & 15)] = (bf16_t)f2bf(ge); }
            }
        }
    }
    if (MODE == 0) {
        f32x2* E = WSP(f32x2, WS_E); const int s = sp + 64 * hi;
        E[((size_t)s * 64 + g) * 64 + col] = (f32x2){h0r, h0i}; E[((size_t)s * 64 + g) * 64 + 32 + col] = (f32x2){h1r, h1i};
    }
    if (MODE == 1) {
        const int s = sp + 64 * hi;
        if ((s & 15) == 15) { const int b = s >> 4;
            F.out[O_S5RE_P + ((size_t)b * 64 + g) * 64 + col] = h0r; F.out[O_S5IM_P + ((size_t)b * 64 + g) * 64 + col] = h0i;
            F.out[O_S5RE_P + ((size_t)b * 64 + g) * 64 + 32 + col] = h1r; F.out[O_S5IM_P + ((size_t)b * 64 + g) * 64 + 32 + col] = h1i; }
    }
}
template <int MODE> __device__ __forceinline__ void phase_s5(Frame& F) {
    for (int t = F.vcu; t < 512; t += F.G) s5_task<MODE>(F, t & 7, t >> 3);
    if (MODE == 1) { for (int t = F.vcu; t < 32; t += F.G) s5_task<2>(F, t & 7, t >> 3); }
    asm volatile("s_waitcnt lgkmcnt(0)" ::: "memory");
}
__device__ __forceinline__ int crow(int r, int hi) { return (r & 3) + 8 * (r >> 2) + 4 * hi; }
template <int PITCH> __device__ __forceinline__ void attn_stage_tile(Frame& F, const bf16_t* __restrict__ src  ) {
    const int r0 = F.tid >> 5, ch = F.tid & 31;
    const bf16_t* g0 = src + (size_t)r0 * PITCH + 8 * ch;
    FLAS unsigned char* l0 = F.lds + r0 * 512 + ((ch ^ (r0 & 15)) << 4);
    u32x4 v[16];
#pragma unroll
    for (int i = 0; i < 16; ++i) v[i] = *(const u32x4*)(g0 + (size_t)(16 * i) * PITCH);
    __builtin_amdgcn_sched_barrier(0);
#pragma unroll
    for (int i = 0; i < 16; ++i) *(FLAS u32x4*)(l0 + i * 8192) = v[i];
    __builtin_amdgcn_sched_barrier(0);
}
__device__ __forceinline__ bf16x8 attn_frag(const FLAS unsigned char* lds, int row, int ch) { return *(const FLAS bf16x8*)(lds + row * 512 + ((ch ^ (row & 15)) << 4)); }
__device__ __forceinline__ void attn_prompt_unit(Frame& F, int layer, int unit) {
    const int lane = F.lane, ql = lane & 31, hh = lane >> 5;
    const int b = unit >> 5, h = (unit >> 3) & 3, qb = unit & 7;
    const bf16_t* QB = WSP(bf16_t, WS_QB); const bf16_t* KB = WSP(bf16_t, WS_KBM) + (size_t)layer * 2048 * D; const bf16_t* VT = WSP(bf16_t, WS_VTM) + (size_t)layer * 8 * 4 * 256 * 256;
    bf16_t* AB = WSP(bf16_t, WS_AB);
    const int row = b * T + qb * 256 + F.wave * 32 + ql;
    const bf16_t* qp = QB + (size_t)row * D + h * 256 + 8 * hh;
    attn_stage_tile<D>(F, KB + ((size_t)b * 256) * D + h * 256);
    asm volatile("s_waitcnt vmcnt(0) lgkmcnt(0)" ::: "memory"); __builtin_amdgcn_s_barrier(); asm volatile("" ::: "memory");
    f32x16 s[8];
#pragma unroll
    for (int kb = 0; kb < 8; ++kb) s[kb] = (f32x16){};
#pragma unroll
    for (int ks = 0; ks < 16; ++ks) {
        bf16x8 kf[8]; const bf16x8 qf = *(const bf16x8*)(qp + 16 * ks);
#pragma unroll
        for (int kb = 0; kb < 8; ++kb) kf[kb] = attn_frag(F.lds, 32 * kb + ql, 2 * ks + hh);
        __builtin_amdgcn_sched_barrier(0);
#pragma unroll
        for (int kb = 0; kb < 8; ++kb) s[kb] = __builtin_amdgcn_mfma_f32_32x32x16_bf16(kf[kb], qf, s[kb], 0, 0, 0);
        __builtin_amdgcn_sched_barrier(0);
    }
    asm volatile("s_waitcnt lgkmcnt(0)" ::: "memory"); __builtin_amdgcn_s_barrier(); asm volatile("" ::: "memory");
    float mx = -3.0e38f;
#pragma unroll
    for (int kb = 0; kb < 8; ++kb)
#pragma unroll
        for (int r = 0; r < 16; ++r) mx = fmaxf(mx, s[kb][r]);
    mx = fmaxf(mx, __shfl_xor(mx, 32));
    float l = 0.f;
    bf16x8 pf[8][2];
#pragma unroll
    for (int kb = 0; kb < 8; ++kb) {
        float p[16];
#pragma unroll
        for (int r = 0; r < 16; ++r) { p[r] = __builtin_amdgcn_exp2f(s[kb][r] - mx); l += p[r]; }
#pragma unroll
        for (int s2 = 0; s2 < 2; ++s2) { u32x4 w; w.x = pk2(p[8 * s2 + 0], p[8 * s2 + 1]); w.y = pk2(p[8 * s2 + 2], p[8 * s2 + 3]); w.z = pk2(p[8 * s2 + 4], p[8 * s2 + 5]); w.w = pk2(p[8 * s2 + 6], p[8 * s2 + 7]);
            pf[kb][s2] = __builtin_bit_cast(bf16x8, w); }
    }
    l += __shfl_xor(l, 32);
    const float inv = 1.0f / l;
    attn_stage_tile<256>(F, VT + (((size_t)b * 4 + h) * 256) * 256);
    asm volatile("s_waitcnt vmcnt(0) lgkmcnt(0)" ::: "memory"); __builtin_amdgcn_s_barrier(); asm volatile("" ::: "memory");
#pragma unroll 1
    for (int half = 0; half < 2; ++half) {
        f32x16 o[4];
#pragma unroll
        for (int i = 0; i < 4; ++i) o[i] = (f32x16){};
#pragma unroll
        for (int st = 0; st < 16; st += 2) {
            bf16x8 vf[8];
#pragma unroll
            for (int j = 0; j < 8; ++j) vf[j] = attn_frag(F.lds, 32 * (4 * half + (j & 3)) + ql, 2 * (st + (j >> 2)) + hh);
            __builtin_amdgcn_sched_barrier(0);
#pragma unroll
            for (int j = 0; j < 8; ++j) o[j & 3] = __builtin_amdgcn_mfma_f32_32x32x16_bf16(vf[j], pf[(st + (j >> 2)) >> 1][(st + (j >> 2)) & 1], o[j & 3], 0, 0, 0);
            __builtin_amdgcn_sched_barrier(0);
        }
#pragma unroll
        for (int i = 0; i < 4; ++i)
#pragma unroll
            for (int r4 = 0; r4 < 4; ++r4) { u32x2 w; w.x = pk2(o[i][4 * r4] * inv, o[i][4 * r4 + 1] * inv); w.y = pk2(o[i][4 * r4 + 2] * inv, o[i][4 * r4 + 3] * inv);
                *(u32x2*)(AB + (size_t)row * D + h * 256 + 32 * (4 * half + i) + 8 * r4 + 4 * hh) = w; }
    }
    asm volatile("s_waitcnt lgkmcnt(0)" ::: "memory"); __builtin_amdgcn_s_barrier(); asm volatile("" ::: "memory");
}
#define TR_LEVEL(N_, SH_) _Pragma("unroll") for (int i = 0; i < (N_); ++i) { const bool up = (lane & (SH_)) != 0; const float keep = up ? v[2 * i + 1] : v[2 * i], send = up ? v[2 * i] : v[2 * i + 1]; v[i] = keep + __shfl_xor(send, (SH_)); }
__device__ __forceinline__ float transpose_reduce64(float (&v)[64], int lane) {
    TR_LEVEL(32, 1) TR_LEVEL(16, 2) TR_LEVEL(8, 4) TR_LEVEL(4, 8) TR_LEVEL(2, 16) TR_LEVEL(1, 32)
    return v[0];
}
__device__ __forceinline__ void attn_sample_unit(Frame& F, int layer, int unit) {
    const int lane = F.lane, w = F.wave, b = unit >> 1, hp = unit & 1, hl = w >> 2, head = 2 * hp + hl, kq = w & 3;
    FLAS float* sc = (FLAS float*)F.lds;
    FLAS float* op = (FLAS float*)(F.lds + 2048);
    FLAS float* ls = (FLAS float*)(F.lds + 2048 + 8192);
    const bf16_t* QB = WSP(bf16_t, WS_QB); bf16_t* AB = WSP(bf16_t, WS_AB);
    const float* Kc = FIN(6) + (((size_t)layer * MS + b) * NMEM + 64 * kq) * D + head * 256 + 4 * lane;
    const float* Vc = FIN(7) + (((size_t)layer * MS + b) * NMEM + 64 * kq) * D + head * 256 + 4 * lane;
    const u32x2 qw = *(const u32x2*)(QB + (size_t)(MP + b) * D + head * 256 + 4 * lane);
    const float q0 = bflo(qw.x), q1 = bfhi(qw.x), q2 = bflo(qw.y), q3 = bfhi(qw.y);
    float v[64];
#pragma unroll
    for (int bt = 0; bt < 4; ++bt) { f32x4 kv[16];
#pragma unroll
        for (int i = 0; i < 16; ++i) kv[i] = __builtin_nontemporal_load((const f32x4*)(Kc + (size_t)(16 * bt + i) * D));
        __builtin_amdgcn_sched_barrier(0);
#pragma unroll
        for (int i = 0; i < 16; ++i) v[16 * bt + i] = (q0 * kv[i][0] + q1 * kv[i][1]) + (q2 * kv[i][2] + q3 * kv[i][3]);
        __builtin_amdgcn_sched_barrier(0); }
    const float sv = transpose_reduce64(v, lane);
    sc[hl * 256 + 64 * kq + lane] = sv;
    asm volatile("s_waitcnt lgkmcnt(0)" ::: "memory"); __builtin_amdgcn_s_barrier(); asm volatile("" ::: "memory");
    float mx = fmaxf(fmaxf(sc[hl * 256 + lane], sc[hl * 256 + 64 + lane]), fmaxf(sc[hl * 256 + 128 + lane], sc[hl * 256 + 192 + lane]));
#pragma unroll
    for (int o = 1; o < 64; o <<= 1) mx = fmaxf(mx, __shfl_xor(mx, o));
    const float pv = __builtin_amdgcn_exp2f(sv - mx);
    const float lpart = wave_sum(pv);
    f32x4 o = {0.f, 0.f, 0.f, 0.f};
#pragma unroll
    for (int bt = 0; bt < 4; ++bt) { f32x4 vv[16];
#pragma unroll
        for (int i = 0; i < 16; ++i) vv[i] = __builtin_nontemporal_load((const f32x4*)(Vc + (size_t)(16 * bt + i) * D));
        __builtin_amdgcn_sched_barrier(0);
#pragma unroll
        for (int i = 0; i < 16; ++i) { const float p = __builtin_bit_cast(float, __builtin_amdgcn_readlane(__builtin_bit_cast(int, pv), 16 * bt + i)); o = o + vv[i] * p; }
        __builtin_amdgcn_sched_barrier(0); }
    *(FLAS f32x4*)(op + (hl * 4 + kq) * 256 + 4 * lane) = o;
    if (lane == 0) ls[hl * 4 + kq] = lpart;
    asm volatile("s_waitcnt lgkmcnt(0)" ::: "memory"); __builtin_amdgcn_s_barrier(); asm volatile("" ::: "memory");
    if (kq == 0) {
        const float inv = 1.0f / ((ls[hl * 4] + ls[hl * 4 + 1]) + (ls[hl * 4 + 2] + ls[hl * 4 + 3]));
        f32x4 t = *(const FLAS f32x4*)(op + (hl * 4) * 256 + 4 * lane);
#pragma unroll
        for (int j = 1; j < 4; ++j) t = t + *(const FLAS f32x4*)(op + (hl * 4 + j) * 256 + 4 * lane);
        u32x2 wv; wv.x = pk2(t[0] * inv, t[1] * inv); wv.y = pk2(t[2] * inv, t[3] * inv);
        *(u32x2*)(AB + (size_t)(MP + b) * D + head * 256 + 4 * lane) = wv;
    }
    asm volatile("s_waitcnt lgkmcnt(0)" ::: "memory"); __builtin_amdgcn_s_barrier(); asm volatile("" ::: "memory");
}
__device__ __forceinline__ void phase_attn(Frame& F, int layer) {
#if defined(ATREP)
    for (int r_ = 0; r_ < (((ATREP) & 1) ? 2 : 0); ++r_) { asm volatile("" ::: "memory"); for (int u = F.vcu; u < 256; u += F.G) attn_prompt_unit(F, layer, u); }
    for (int r_ = 0; r_ < (((ATREP) & 2) ? 2 : 0); ++r_) { asm volatile("" ::: "memory"); for (int u = F.vcu; u < 256; u += F.G) attn_sample_unit(F, layer, u); }
#endif
    for (int u = F.vcu; u < 256; u += F.G) attn_prompt_unit(F, layer, u);
    for (int u = F.vcu; u < 256; u += F.G) attn_sample_unit(F, layer, u);
}

constexpr int VRS = 320;
__device__ __forceinline__ void stage_v_tile(Frame& F, FLAS unsigned char* vt, int row0, int h) {
    const bf16_t* VN = WSP(bf16_t, WS_VT);
#pragma unroll
    for (int i = 0; i < 2; ++i) { const int r = 8 * F.wave + 4 * i + (F.lane >> 4), ch = F.lane & 15;
        const u32x4 v = *(const u32x4*)(VN + (size_t)(row0 + r) * D + h * 128 + 8 * ch); *(FLAS u32x4*)(vt + r * VRS + 16 * ch) = v; }
}
typedef short v4i16_t __attribute__((ext_vector_type(4)));
__device__ __forceinline__ bf16x8 vt_frag(const FLAS unsigned char* vt, int vb, int ts, int lane) {
    const int hh = lane >> 5, q = (lane & 15) >> 2, p = lane & 3, cb = 32 * vb + 16 * ((lane >> 4) & 1);
    const FLAS unsigned char* a0 = vt + (16 * ts + 4 * hh + q) * VRS + 2 * (cb + 4 * p);
    const v4i16_t lo = __builtin_amdgcn_ds_read_tr16_b64_v4i16((FLAS v4i16_t*)a0);
    const v4i16_t hi = __builtin_amdgcn_ds_read_tr16_b64_v4i16((FLAS v4i16_t*)(a0 + 8 * VRS));
    return (bf16x8){lo[0], lo[1], lo[2], lo[3], hi[0], hi[1], hi[2], hi[3]};
}
__device__ __forceinline__ void hga_unit(Frame& F, int unit) {
    const int lane = F.lane, w = F.wave, kb = w & 3, vh = w >> 2, kc = lane & 31, hh = lane >> 5;
    const int bh = unit >> 5, n = unit & 31, b = bh >> 3, h = bh & 7;
    FLAS unsigned char* vt = F.lds;
    const _Float16* LOGF = WSP(_Float16, WS_LOGF) + ((size_t)b * T + n * 64) * D + h * 128 + 32 * kb + kc;
    float kd[64]; float suf = 0.f;
#pragma unroll
    for (int t = 0; t < 64; ++t) kd[t] = (float)LOGF[(size_t)t * D];
    __builtin_amdgcn_sched_barrier(0);
    stage_v_tile(F, vt, b * T + n * 64, h);
    __builtin_amdgcn_sched_barrier(0);
#pragma unroll
    for (int t = 63; t >= 0; --t) { const float lf = kd[t]; kd[t] = (1.0f - fast_exp(lf)) * fast_exp(suf); suf += lf; }
    bf16x8 kf[4];
#pragma unroll
    for (int ts = 0; ts < 4; ++ts) { float e[8];
#pragma unroll
        for (int j = 0; j < 8; ++j) { const int tlo = 16 * ts + 8 * (j >> 2) + (j & 3); e[j] = hh ? kd[tlo + 4] : kd[tlo]; }
        u32x4 wv; wv.x = pk2(e[0], e[1]); wv.y = pk2(e[2], e[3]); wv.z = pk2(e[4], e[5]); wv.w = pk2(e[6], e[7]); kf[ts] = __builtin_bit_cast(bf16x8, wv); }
    asm volatile("s_waitcnt vmcnt(0) lgkmcnt(0)" ::: "memory"); __builtin_amdgcn_s_barrier(); asm volatile("" ::: "memory");
    bf16_t* SL = WSP(bf16_t, WS_SLOC) + (size_t)unit * 16384;
#pragma unroll
    for (int vi = 0; vi < 2; ++vi) { const int vb = 2 * vh + vi; f32x16 acc = {};
#pragma unroll
        for (int ts = 0; ts < 4; ++ts) { const bf16x8 vf = vt_frag(vt, vb, ts, lane); acc = __builtin_amdgcn_mfma_f32_32x32x16_bf16(vf, kf[ts], acc, 0, 0, 0); }
#pragma unroll
        for (int r = 0; r < 16; ++r) SL[(size_t)(32 * vb + crow(r, hh)) * 128 + 32 * kb + kc] = (bf16_t)f2bf(acc[r]); }
    if (vh == 0 && hh == 0) WSP(float, WS_BT)[(size_t)unit * 128 + 32 * kb + kc] = suf;
    asm volatile("s_waitcnt lgkmcnt(0)" ::: "memory"); __builtin_amdgcn_s_barrier(); asm volatile("" ::: "memory");
}
__device__ __forceinline__ void phase_hgb(Frame& F) {
    const bf16_t* SL = WSP(bf16_t, WS_SLOC); const float* BT = WSP(float, WS_BT); bf16_t* SST = WSP(bf16_t, WS_SST);
    for (int chain = F.vcu * NTHR + F.tid; chain < 64 * 128 * 32; chain += F.G * NTHR) {
        const int bh = chain >> 12, v = (chain >> 5) & 127, k4 = chain & 31;
        f32x4 S = {0.f, 0.f, 0.f, 0.f};
        for (int n = 0; n < 32; ++n) {
            const size_t u = (size_t)bh * 32 + n;
            u32x2 wv; wv.x = pk2(S[0], S[1]); wv.y = pk2(S[2], S[3]); *(u32x2*)(SST + u * 16384 + v * 128 + 4 * k4) = wv;
            const u32x2 lw_ = *(const u32x2*)(SL + u * 16384 + v * 128 + 4 * k4); const f32x4 loc = {bflo(lw_.x), bfhi(lw_.x), bflo(lw_.y), bfhi(lw_.y)}, bt = *(const f32x4*)(BT + u * 128 + 4 * k4);
#pragma unroll
            for (int i = 0; i < 4; ++i) S[i] = fast_exp(bt[i]) * S[i] + loc[i];
        }
#pragma unroll
        for (int i = 0; i < 4; ++i) F.out[O_HG_P + ((size_t)bh * 128 + 4 * k4 + i) * 128 + v] = S[i];
    }
}
constexpr int HC_RS = 272;
struct HgcPre { u32x4 lf[2]; u32x4 q[2]; u32x4 v[2]; bf16x8 sa[8]; u32x2 g[4]; };
__device__ __forceinline__ void hgc_prefetch(Frame& F, int unit, HgcPre& P) {
    const int lane = F.lane, w = F.wave;
    const int bh = unit >> 5, n = unit & 31, b = bh >> 3, h = bh & 7, row0 = b * T + n * 64;
    const size_t off = (size_t)(row0 + lane) * D + h * 128 + 16 * w;
    P.lf[0] = *(const u32x4*)(WSP(unsigned short, WS_LOGF) + off); P.lf[1] = *(const u32x4*)(WSP(unsigned short, WS_LOGF) + off + 8);
    P.q[0] = *(const u32x4*)(WSP(bf16_t, WS_QB) + off); P.q[1] = *(const u32x4*)(WSP(bf16_t, WS_QB) + off + 8);
#pragma unroll
    for (int i = 0; i < 2; ++i) { const int r = 8 * w + 4 * i + (lane >> 4), ch = lane & 15; P.v[i] = *(const u32x4*)(WSP(bf16_t, WS_VT) + (size_t)(row0 + r) * D + h * 128 + 8 * ch); }
    const int tb = w & 1, vb = w >> 1, tl = lane & 31, hh = lane >> 5;
    const bf16_t* SST = WSP(bf16_t, WS_SST) + (size_t)unit * 16384 + (size_t)(32 * vb + tl) * 128 + 8 * hh;
#pragma unroll
    for (int ks = 0; ks < 8; ++ks) P.sa[ks] = *(const bf16x8*)(SST + 16 * ks);
    const size_t orow = (size_t)(row0 + 32 * tb + tl) * D + h * 128 + 32 * vb;
#pragma unroll
    for (int r4 = 0; r4 < 4; ++r4) P.g[r4] = *(const u32x2*)(WSP(bf16_t, WS_GH) + orow + 8 * r4 + 4 * hh);
}
__device__ __forceinline__ void hgc_unit(Frame& F, int unit, const HgcPre& P) {
    const int lane = F.lane, w = F.wave;
    const int bh = unit >> 5, n = unit & 31, b = bh >> 3, h = bh & 7;
    FLAS unsigned char* QM = F.lds, *KM = F.lds + 64 * HC_RS, *QHT = F.lds + 128 * HC_RS;
    FLAS float* part = (FLAS float*)(F.lds + 192 * HC_RS);
    FLAS unsigned char* vt = F.lds + 192 * HC_RS + 1024;
    const int row0 = b * T + n * 64;
#pragma unroll
    for (int i = 0; i < 2; ++i) { const int r = 8 * w + 4 * i + (lane >> 4), ch = lane & 15; *(FLAS u32x4*)(vt + r * VRS + 16 * ch) = P.v[i]; }
    {
        float bc[16], kk[16];
#pragma unroll
        for (int i = 0; i < 2; ++i) { const u32x4 v = P.lf[i]; bc[8 * i] = hlo(v.x); bc[8 * i + 1] = hhi(v.x); bc[8 * i + 2] = hlo(v.y); bc[8 * i + 3] = hhi(v.y); bc[8 * i + 4] = hlo(v.z); bc[8 * i + 5] = hhi(v.z); bc[8 * i + 6] = hlo(v.w); bc[8 * i + 7] = hhi(v.w); }
#pragma unroll
        for (int i = 0; i < 16; ++i) kk[i] = 1.0f - fast_exp(bc[i]);
#pragma unroll
        for (int d = 1; d < 64; d <<= 1) {
#pragma unroll
            for (int i = 0; i < 16; ++i) { const float o = __shfl_up(bc[i], d); if (lane >= d) bc[i] += o; }
        }
        const u32x4 qw0 = P.q[0], qw1 = P.q[1];
        float q[16];
        q[0] = bflo(qw0.x); q[1] = bfhi(qw0.x); q[2] = bflo(qw0.y); q[3] = bfhi(qw0.y); q[4] = bflo(qw0.z); q[5] = bfhi(qw0.z); q[6] = bflo(qw0.w); q[7] = bfhi(qw0.w);
        q[8] = bflo(qw1.x); q[9] = bfhi(qw1.x); q[10] = bflo(qw1.y); q[11] = bfhi(qw1.y); q[12] = bflo(qw1.z); q[13] = bfhi(qw1.z); q[14] = bflo(qw1.w); q[15] = bfhi(qw1.w);
        float qm[16], km[16], qh[16];
#pragma unroll
        for (int i = 0; i < 16; ++i) { const float bm = __shfl(bc[i], 31); qm[i] = q[i] * fast_exp(bc[i] - bm); km[i] = kk[i] * fast_exp(bm - bc[i]); qh[i] = q[i] * fast_exp(bc[i]); }
#define HC_PACK8(a, o_) ((u32x4){pk2(a[o_], a[o_ + 1]), pk2(a[o_ + 2], a[o_ + 3]), pk2(a[o_ + 4], a[o_ + 5]), pk2(a[o_ + 6], a[o_ + 7])})
        *(FLAS u32x4*)(QM + lane * HC_RS + 32 * w) = HC_PACK8(qm, 0); *(FLAS u32x4*)(QM + lane * HC_RS + 32 * w + 16) = HC_PACK8(qm, 8);
        *(FLAS u32x4*)(KM + lane * HC_RS + 32 * w) = HC_PACK8(km, 0); *(FLAS u32x4*)(KM + lane * HC_RS + 32 * w + 16) = HC_PACK8(km, 8);
        *(FLAS u32x4*)(QHT + lane * HC_RS + 32 * w) = HC_PACK8(qh, 0); *(FLAS u32x4*)(QHT + lane * HC_RS + 32 * w + 16) = HC_PACK8(qh, 8);
    }
    asm volatile("s_waitcnt lgkmcnt(0)" ::: "memory"); __builtin_amdgcn_s_barrier(); asm volatile("" ::: "memory");
    const int tb = w & 1, vb = w >> 1, tl = lane & 31, hh = lane >> 5, tglob = 32 * tb + tl;
    f32x16 acc = {};
#pragma unroll
    for (int ks = 0; ks < 8; ++ks) { const bf16x8 bq = *(const FLAS bf16x8*)(QHT + tglob * HC_RS + 32 * ks + 16 * hh);
        acc = __builtin_amdgcn_mfma_f32_32x32x16_bf16(P.sa[ks], bq, acc, 0, 0, 0); }
#pragma unroll
    for (int sb = 0; sb < 2; ++sb) {
        if (sb <= tb) {
            f32x16 x = {};
#pragma unroll
            for (int ks = 0; ks < 8; ++ks) { const bf16x8 a = *(const FLAS bf16x8*)(KM + (32 * sb + tl) * HC_RS + 32 * ks + 16 * hh); const bf16x8 bq = *(const FLAS bf16x8*)(QM + tglob * HC_RS + 32 * ks + 16 * hh);
                x = __builtin_amdgcn_mfma_f32_32x32x16_bf16(a, bq, x, 0, 0, 0); }
            if (sb == tb) {
#pragma unroll
                for (int r = 0; r < 16; ++r) if (crow(r, hh) > tl) x[r] = 0.f;
            }
#pragma unroll
            for (int s2 = 0; s2 < 2; ++s2) { u32x4 wv; wv.x = pk2(x[8 * s2], x[8 * s2 + 1]); wv.y = pk2(x[8 * s2 + 2], x[8 * s2 + 3]); wv.z = pk2(x[8 * s2 + 4], x[8 * s2 + 5]); wv.w = pk2(x[8 * s2 + 6], x[8 * s2 + 7]);
                const bf16x8 a = vt_frag(vt, vb, 2 * sb + s2, lane);
                acc = __builtin_amdgcn_mfma_f32_32x32x16_bf16(a, __builtin_bit_cast(bf16x8, wv), acc, 0, 0, 0); }
        }
    }
    float sq = 0.f;
#pragma unroll
    for (int r = 0; r < 16; ++r) sq += acc[r] * acc[r];
    sq += __shfl_xor(sq, 32);
    if (hh == 0) part[vb * 64 + tglob] = sq;
    asm volatile("s_waitcnt lgkmcnt(0)" ::: "memory"); __builtin_amdgcn_s_barrier(); asm volatile("" ::: "memory");
    const float tot = (part[tglob] + part[64 + tglob]) + (part[128 + tglob] + part[192 + tglob]);
    const float rs = 1.0f / sqrtf(tot * (1.0f / 128.0f) + EPS);
    const size_t orow = (size_t)(row0 + tglob) * D + h * 128 + 32 * vb;
    const float* ng = FIN(31);
#pragma unroll
    for (int r4 = 0; r4 < 4; ++r4) { const int v0 = 8 * r4 + 4 * hh;
        const u32x2 gw = P.g[r4]; const f32x4 gn = *(const f32x4*)(ng + 32 * vb + v0);
        u32x2 wv; wv.x = pk2(acc[4 * r4] * rs * gn[0] * bflo(gw.x), acc[4 * r4 + 1] * rs * gn[1] * bfhi(gw.x)); wv.y = pk2(acc[4 * r4 + 2] * rs * gn[2] * bflo(gw.y), acc[4 * r4 + 3] * rs * gn[3] * bfhi(gw.y));
        *(u32x2*)(WSP(bf16_t, WS_AB) + orow + v0) = wv; }
    asm volatile("s_waitcnt lgkmcnt(0)" ::: "memory"); __builtin_amdgcn_s_barrier(); asm volatile("" ::: "memory");
}
__device__ __forceinline__ void phase_hgc(Frame& F) {
    HgcPre P; int u = F.vcu;
    if (u < 2048) hgc_prefetch(F, u, P);
    for (; u < 2048; u += F.G) {
        const HgcPre C = P; const int un = u + F.G;
        if (un < 2048) hgc_prefetch(F, un, P);
        __builtin_amdgcn_sched_barrier(0);
        hgc_unit(F, u, C);
    }
}
__device__ __forceinline__ void hg_sample_wave(Frame& F, int unit) {
    const int lane = F.lane, b = unit >> 3, h = unit & 7, v4 = lane & 31, kp = lane >> 5;
    const size_t rowo = (size_t)(MP + b) * D + h * 128;
    const float* S0 = FIN(5) + ((size_t)unit * 128) * 128 + 4 * v4; float* So = F.out + O_HG_S + ((size_t)unit * 128) * 128 + 4 * v4;
    const unsigned lfw_ = *(const unsigned*)(WSP(unsigned short, WS_LOGF) + rowo + 2 * lane); const f32x2 lfp = {hlo(lfw_), hhi(lfw_)};
    const unsigned qp = *(const unsigned*)(WSP(bf16_t, WS_QB) + rowo + 2 * lane);
    const u32x2 vw_ = *(const u32x2*)(WSP(bf16_t, WS_VT) + rowo + 4 * v4); const f32x4 vv = {bflo(vw_.x), bfhi(vw_.x), bflo(vw_.y), bfhi(vw_.y)};
    const u32x2 gw = *(const u32x2*)(WSP(bf16_t, WS_GH) + rowo + 4 * v4); const f32x4 gn = *(const f32x4*)(FIN(31) + 4 * v4);
    const float fx = fast_exp(lfp[0]), fy = fast_exp(lfp[1]), qx = bflo(qp), qy = bfhi(qp);
    f32x4 o = {0.f, 0.f, 0.f, 0.f};
#pragma unroll
    for (int it = 0; it < 4; ++it) {
        f32x4 s0[16];
#pragma unroll
        for (int i = 0; i < 16; ++i) s0[i] = __builtin_nontemporal_load((const f32x4*)(S0 + (size_t)(32 * it + 2 * i + kp) * 128));
        __builtin_amdgcn_sched_barrier(0);
#pragma unroll
        for (int i = 0; i < 16; ++i) { const int src = 16 * it + i;
            const float f0 = __builtin_bit_cast(float, __builtin_amdgcn_readlane(__builtin_bit_cast(int, fx), src)), f1 = __builtin_bit_cast(float, __builtin_amdgcn_readlane(__builtin_bit_cast(int, fy), src));
            const float q0 = __builtin_bit_cast(float, __builtin_amdgcn_readlane(__builtin_bit_cast(int, qx), src)), q1 = __builtin_bit_cast(float, __builtin_amdgcn_readlane(__builtin_bit_cast(int, qy), src));
            const float f = kp ? f1 : f0, q = kp ? q1 : q0, kk = 1.0f - f;
            const f32x4 sn = s0[i] * f + vv * kk;
            __builtin_nontemporal_store(sn, (f32x4*)(So + (size_t)(32 * it + 2 * i + kp) * 128)); o = o + sn * q; }
        __builtin_amdgcn_sched_barrier(0);
    }
#pragma unroll
    for (int j = 0; j < 4; ++j) o[j] += __shfl_xor(o[j], 32);
    float sq = (o[0] * o[0] + o[1] * o[1]) + (o[2] * o[2] + o[3] * o[3]);
    sq += __shfl_xor(sq, 1); sq += __shfl_xor(sq, 2); sq += __shfl_xor(sq, 4); sq += __shfl_xor(sq, 8); sq += __shfl_xor(sq, 16);
    const float rs = 1.0f / sqrtf(sq * (1.0f / 128.0f) + EPS);
    if (kp == 0) { u32x2 wv; wv.x = pk2(o[0] * rs * gn[0] * bflo(gw.x), o[1] * rs * gn[1] * bfhi(gw.x)); wv.y = pk2(o[2] * rs * gn[2] * bflo(gw.y), o[3] * rs * gn[3] * bfhi(gw.y));
        *(u32x2*)(WSP(bf16_t, WS_AB) + rowo + 4 * v4) = wv; }
}
__device__ __forceinline__ void phase_final(Frame& F) {
    const int gw = F.vcu * NWAVES + F.wave, NGW = F.G * NWAVES, lane = F.lane;
    const bf16_t* XBp = WSP(bf16_t, WS_XB); const float* SSQ = WSP(float, WS_SSQ); const float* g = FIN(33);
    for (int row = gw; row < R; row += NGW) {
        const float rs = row < MP ? row_rstd<16>(SSQ, row) : srow_rstd(WSP(float, WS_SSQS), row - MP);
#pragma unroll
        for (int j = 0; j < 2; ++j) { f32x4 v0, v1; bf8_to_f32(((const u32x4*)(XBp + (size_t)row * D))[lane + 64 * j], v0, v1);
            const f32x4 g0 = ((const f32x4*)g)[2 * (lane + 64 * j)], g1 = ((const f32x4*)g)[2 * (lane + 64 * j) + 1];
            ((f32x4*)(F.out + (size_t)row * D))[2 * (lane + 64 * j)] = v0 * rs * g0; ((f32x4*)(F.out + (size_t)row * D))[2 * (lane + 64 * j) + 1] = v1 * rs * g1; }
    }
}
constexpr int NPHASE = 24;
#ifndef PHM
#define PHM 0xFFFFFFu
#endif
#define PHON(k) (((PHM) >> (k)) & 1u)
__global__ void __launch_bounds__(NTHR, 2) mega(Args args) {
    extern __shared__ __attribute__((aligned(16))) unsigned char lds_raw[];
    Frame F;
    F.lds = (FLAS unsigned char*)lds_raw;
    F.tid = threadIdx.x; F.lane = F.tid & 63; F.wave = __builtin_amdgcn_readfirstlane(F.tid >> 6);
    const int wave_s = F.wave;
    F.G = gridDim.x; { const int bx = blockIdx.x; F.vcu = (F.G % 8 == 0) ? (bx % 8) * (F.G / 8) + bx / 8 : bx; }
    { KAS const char* ka0 = (KAS const char*)__builtin_amdgcn_kernarg_segment_ptr(); F.ka = ka0; F.out = *(float* KAS const*)(ka0 + 272); F.ws = *(unsigned char* KAS const*)(ka0 + 280); }
    volatile FLAS unsigned* MISC = (volatile FLAS unsigned*)(F.lds + MISC_OFF);
    for (int u = F.tid; u < (LDS_BYTES - LDSCTL_OFF) / 4; u += NTHR) ((FLAS unsigned*)(F.lds + LDSCTL_OFF))[u] = 0u;
    __syncthreads();
    XcdBarrier bar = xcd_barrier_post((unsigned*)(F.ws + WS_CTL) + 4096 + args.ph_lo * XCD_BAR_WORDS, MISC + 8, F.tid == 0);
    const int bx0 = (int)blockIdx.x, G0 = F.G, vcu0 = F.vcu;
#if defined(REPM)
    int rl_ = -1;
#endif
#if defined(PHT)
    unsigned long long pht_acc_ = 0ull;
#endif
#pragma nounroll
    for (int ph = args.ph_lo; ph < args.ph_hi; ++ph) {
        int bx = bx0, G_ = G0, vcu_ = vcu0, wv_ = wave_s;
        asm volatile("" : "+s"(bx), "+s"(G_), "+s"(vcu_), "+s"(wv_));
        F.G = G_; F.vcu = vcu_;
        { int l_ = (int)__builtin_amdgcn_mbcnt_hi(~0u, __builtin_amdgcn_mbcnt_lo(~0u, 0u)); asm volatile("" : "+v"(l_)); F.lane = l_; F.wave = wv_; F.tid = wv_ * 64 + l_;
          KAS const char* ka_ = (KAS const char*)__builtin_amdgcn_kernarg_segment_ptr(); asm volatile("" : "+s"(ka_)); F.ka = ka_;
          F.out = *(float* KAS const*)(ka_ + 272); F.ws = *(unsigned char* KAS const*)(ka_ + 280); }
        bf16_t* XB = WSP(bf16_t, WS_XB); float* SSQ = WSP(float, WS_SSQ); float* SSQS = WSP(float, WS_SSQS); bf16_t* HB = WSP(bf16_t, WS_HB); bf16_t* AB = WSP(bf16_t, WS_AB); bf16_t* QB = WSP(bf16_t, WS_QB);
        const int layer = ph >= 11 ? 1 : 0;
#if defined(PHT)
        const unsigned long long pt0_ = __builtin_amdgcn_s_memrealtime();
#endif
#define SKINNY(PAIRED_, KS_, NT_, EPI_, A_, BT_, NU_, NCU_) do { int ln_ = F.lane; asm volatile("" : "+v"(ln_)); const auto e_ = EPI_; if (G_ - 1 - bx < (NCU_)) for (int u_ = G_ - 1 - bx; u_ < (NU_); u_ += (NCU_)) skinny_unit<PAIRED_, KS_, NT_>(A_, BT_, u_, F.wave, ln_, F.lds, e_); } while (0)
        if (ph == 0) { if (PHON(0)) phase_prep(F); }
        else if (PHON(1) && (ph == 1 || ph == 9 || ph == 11 || ph == 21)) {
            const bool second = (ph == 9 || ph == 21);
            const bf16_t* Bt = WSP(bf16_t, (second ? WS_W2IN : WS_W1IN) + layer * W1IN_SZ);
            pg8::Gemm g{XB, Bt, MP, 2 * FF, D}; pg8::StaticOrder S; S.init(MP, 2 * FF, F.G, bx);
            EpiSwiglu<16> E{SSQ, HB};
            pg8::gemm_phase<EpiSwiglu<16>, pg8::StaticOrder, true, true>(F.lds, g, S, E, F.tid);
            SKINNY(true, 8, 2, (SEpiSwiglu{SSQS, HB}), XB, Bt, 4 * FF / 32, 128);
        } else if (PHON(2) && (ph == 2 || ph == 10 || ph == 12 || ph == 22 || ph == 8 || ph == 20 || ph == 17)) {
            const bool ffn = (ph == 2 || ph == 10 || ph == 12 || ph == 22);
            const bf16_t* A; const bf16_t* Bt; int K; float sc;
            if (ffn) { const bool second = (ph == 10 || ph == 22); A = HB; Bt = WSP(bf16_t, (second ? WS_W2OUT : WS_W1OUT) + layer * W1OUT_SZ); K = FF; sc = 0.5f; }
            else if (ph == 17) { A = AB; Bt = WSP(bf16_t, WS_WHGOUT); K = D; sc = 1.0f; }
            else { A = AB; Bt = WSP(bf16_t, WS_WO + layer * WQ_SZ); K = D; sc = 1.0f; }
#if defined(REPM)
            if (rl_ >= 0) sc = 0.f;
#endif
            pg8::Gemm g{A, Bt, MP, D, K}; pg8::StaticOrder S; S.init(MP, D, F.G, bx);
            EpiResid E{XB, SSQ, sc};
            pg8::gemm_phase<EpiResid, pg8::StaticOrder, true, true>(F.lds, g, S, E, F.tid);
            if (K == D) SKINNY(false, 8, 1, (SEpiResid{XB, SSQS, sc}), A, Bt, 4 * D / 16, 256); else SKINNY(false, 22, 1, (SEpiResid{XB, SSQS, sc}), A, Bt, 4 * D / 16, 256);
            if (PHON(20) && ph == 2) {
                pg8::Gemm g2{WSP(bf16_t, WS_MEMN), WSP(bf16_t, WS_WKV), 2048, 4096, D}; pg8::StaticOrder S2; S2.init(2048, 4096, F.G, F.G - 1 - bx);
                EpiMemKV E2{F.out, WSP(bf16_t, WS_KBM), WSP(bf16_t, WS_VTM)};
                pg8::gemm_phase<EpiMemKV, pg8::StaticOrder, true, true>(F.lds, g2, S2, E2, F.tid);
            }
        } else if (PHON(3) && ph == 3) phase_s5<0>(F);
        else if (PHON(4) && ph == 4) phase_s5<1>(F);
        else if (PHON(5) && ph == 5) {
            pg8::Gemm g{AB, WSP(bf16_t, WS_WGLU), MP, 2 * D, D}; pg8::StaticOrder S; S.init(MP, 2 * D, F.G, bx);
            EpiGlu E{XB, SSQ};
            pg8::gemm_phase<EpiGlu, pg8::StaticOrder, true, true>(F.lds, g, S, E, F.tid);
            SKINNY(true, 8, 1, (SEpiGlu{XB, SSQS}), AB, WSP(bf16_t, WS_WGLU), 4 * D / 16, 256);
        } else if (PHON(6) && (ph == 6 || ph == 18)) {
            const bf16_t* Bt = WSP(bf16_t, WS_WQ + layer * WQ_SZ);
            pg8::Gemm g{XB, Bt, MP, D, D}; pg8::StaticOrder S; S.init(MP, D, F.G, bx);
            if (ph == 6) { EpiQ<32> E{SSQ, QB}; pg8::gemm_phase<EpiQ<32>, pg8::StaticOrder, true, true>(F.lds, g, S, E, F.tid); }
            else { EpiQ<16> E{SSQ, QB}; pg8::gemm_phase<EpiQ<16>, pg8::StaticOrder, true, true>(F.lds, g, S, E, F.tid); }
            SKINNY(false, 8, 1, (SEpiQ{SSQS, QB}), XB, Bt, 4 * D / 16, 256);
        } else if (PHON(7) && (ph == 7 || ph == 19)) phase_attn(F, layer);
        else if (PHON(13) && ph == 13) {
            pg8::Gemm g{XB, WSP(bf16_t, WS_WHGIN), MP, 4 * D, D}; pg8::StaticOrder S; S.init(MP, 4 * D, F.G, bx);
            EpiHgIn<16> E{SSQ, WSP(float, WS_LB), QB, WSP(unsigned short, WS_LOGF), WSP(bf16_t, WS_VT), WSP(bf16_t, WS_GH)};
            pg8::gemm_phase<EpiHgIn<16>, pg8::StaticOrder, true, true>(F.lds, g, S, E, F.tid);
            SKINNY(false, 8, 2, (SEpiHgIn{SSQS, WSP(float, WS_LB), QB, WSP(unsigned short, WS_LOGF), WSP(bf16_t, WS_VT), WSP(bf16_t, WS_GH)}), XB, WSP(bf16_t, WS_WHGIN), 4 * 4 * D / 32, 256);
        } else if (PHON(14) && ph == 14) { for (int u = F.vcu; u < 2048; u += F.G) hga_unit(F, u); }
        else if (PHON(15) && ph == 15) phase_hgb(F);
        else if (PHON(16) && ph == 16) {
#if defined(HGREP)
            for (int r_ = 0; r_ < (((HGREP) & 1) ? 2 : 0); ++r_) { asm volatile("" ::: "memory"); phase_hgc(F); }
            for (int r_ = 0; r_ < (((HGREP) & 2) ? 2 : 0); ++r_) { asm volatile("" ::: "memory"); for (int u = F.vcu * NWAVES + F.wave; u < 1024; u += F.G * NWAVES) hg_sample_wave(F, u); }
#endif
            phase_hgc(F); for (int u = F.vcu * NWAVES + F.wave; u < 1024; u += F.G * NWAVES) hg_sample_wave(F, u); }
        else if (PHON(23) && ph == 23) phase_final(F);
#if defined(REPM)
        if (rl_ < 0) rl_ = (int)(((unsigned)(REPM) >> ph) & 1u) * (REPN);
        if (rl_ > 0) { --rl_; --ph; continue; }
        rl_ = -1;
#endif
        if (ph + 1 < args.ph_hi) xcd_barrier(bar, F.tid == 0);
#if defined(PHT)
        if (((unsigned)(PHT) >> ph) & 1u) pht_acc_ += __builtin_amdgcn_s_memrealtime() - pt0_;
#endif
    }
#if defined(PHT)
    if (blockIdx.x == 0) { const unsigned long long te_ = __builtin_amdgcn_s_memrealtime(); while (__builtin_amdgcn_s_memrealtime() - te_ < 4ull * pht_acc_) __builtin_amdgcn_s_sleep(8); }
#endif
}

static int g_grid = 0;
static inline bool launch_setup() {
    if (g_grid == 0) {
        int dev = 0, cus = 0, per_cu = 0;
        if (hipGetDevice(&dev) != hipSuccess || hipDeviceGetAttribute(&cus, hipDeviceAttributeMultiprocessorCount, dev) != hipSuccess) { fprintf(stderr, "kernel_launch: device query failed\n"); g_grid = -1; return false; }
        if (hipFuncSetAttribute((const void*)mega, hipFuncAttributeMaxDynamicSharedMemorySize, LDS_BYTES) != hipSuccess) { fprintf(stderr, "kernel_launch: hipFuncSetAttribute failed\n"); g_grid = -1; return false; }
        if (hipOccupancyMaxActiveBlocksPerMultiprocessor(&per_cu, (const void*)mega, NTHR, LDS_BYTES) != hipSuccess || per_cu < 1) { fprintf(stderr, "kernel_launch: occupancy query says %d blocks/CU\n", per_cu); }
        (void)hipGetLastError();
        g_grid = cus;
        fprintf(stderr, "kernel_launch: grid %d, occupancy query %d per CU\n", g_grid, per_cu);
    }
    return g_grid > 0;
}
static inline void launch_phases(void* const* d_in, float* out, void* d_ws, int lo, int hi, hipStream_t st) {
    Args a{};
    for (int i = 0; i < 34; ++i) a.in[i] = (const float*)d_in[i];
    a.out = out; a.ws = (unsigned char*)d_ws; a.ph_lo = lo; a.ph_hi = hi;
    hipLaunchKernelGGL(mega, dim3(g_grid), dim3(NTHR), LDS_BYTES, st, a);
}
}
#if defined(DBG_BUILD)
#define WS_NEED_MIB 1020
#else
#define WS_NEED_MIB 616
#endif
extern "C" void kernel_launch(void* const* d_in, const int* in_sizes, int n_in, void* d_out, int out_size, void* d_ws, size_t ws_size, hipStream_t stream) {
    if (n_in != 34 || out_size != 44236800 || ws_size < ((size_t)WS_NEED_MIB << 20)) { fprintf(stderr, "kernel_launch: unexpected sizes n_in=%d out=%d ws=%zu\n", n_in, out_size, ws_size); return; }
    if (!fk::launch_setup()) return;
    hipMemsetAsync((char*)d_ws + fk::WS_CTL, 0, fk::CTL_ZERO_BYTES, stream);
#if defined(DBG_BUILD)
    dbg::forward(d_in, (float*)d_out, (unsigned char*)d_ws, stream);
#else
    fk::launch_phases(d_in, (float*)d_out, d_ws, 0, fk::NPHASE, stream);
#endif
}
```

```cpp
#include <hip/hip_runtime.h>
#include <cstdio>
#include <cstdint>
#include <cmath>
namespace gold {
__device__ __forceinline__ double d_exp(double x) {
    const double LN2 = 0.6931471805599453094172321, ILN2 = 1.4426950408889634073599247;
    double n = __builtin_rint(x * ILN2);
    double r = x - n * LN2;
    double s = 1.0, term = 1.0;
#pragma unroll
    for (int i = 1; i <= 16; ++i) { term *= r / (double)i; s += term; }
    long long e = (long long)n + 1023;
    double sc = __builtin_bit_cast(double, (unsigned long long)e << 52);
    return s * sc;
}
__device__ __forceinline__ void d_sincos(double th, double& sn, double& cs) {
    const double HPI = 1.5707963267948966192313217, IHPI = 0.63661977236758134307553505;
    double q = __builtin_rint(th * IHPI);
    double r = th - q * HPI;
    double r2 = r * r;
    double s = 0.0, c = 0.0;
    double ts = r, tc = 1.0; s = ts; c = tc;
#pragma unroll
    for (int i = 1; i <= 9; ++i) { tc *= -r2 / (double)((2 * i - 1) * (2 * i)); c += tc; ts *= -r2 / (double)((2 * i) * (2 * i + 1)); s += ts; }
    int qi = ((int)q) & 3;
    if (qi == 0) { sn = s; cs = c; } else if (qi == 1) { sn = c; cs = -s; } else if (qi == 2) { sn = -s; cs = -c; } else { sn = -c; cs = s; }
}
}
namespace pg8 {
#define PG8_LAS __attribute__((address_space(3)))
typedef unsigned short bf16_t;
typedef short bf16x8 __attribute__((ext_vector_type(8)));
typedef float f32x4 __attribute__((ext_vector_type(4)));
typedef unsigned u32x4 __attribute__((ext_vector_type(4)));
constexpr int BM = 256, BK = 64, HALF = 128, HTB = HALF * BK * 2  , STAGE_BYTES = 8 * HTB, NXCD = 8, WGM = 8;

__host__ __device__ __forceinline__ int lds_byte(int r, int c) { const int st = (r >> 4) * 2 + (c >> 5), rr = r & 15, cc = c & 31, ob = rr * 64 + cc * 2; return st * 1024 + (ob ^ (((ob >> 9) & 1) << 5)); }
__host__ __device__ __forceinline__ void stage_rc(int b, int& R, int& C) { const int st = b / 1024, sb = b % 1024, swz = sb ^ (((sb >> 9) & 1) << 5); R = (st >> 1) * 16 + swz / 64; C = (st & 1) * 32 + (swz % 64) / 2; }
__host__ __device__ __forceinline__ int perm32(int rho) { const int n = rho >> 4, i = rho & 15; return 8 * (i >> 2) + 4 * n + (i & 3); }

struct Unit { int pm, pn; };
struct Gemm { const bf16_t* A; const bf16_t* Bt; int M, N, K; };

struct StaticOrder {
    int nM, nN, nwg, G, c;
    __host__ __device__ void init(int M, int N, int G_, int c_) { nM = M / BM; nN = N / BM; nwg = nM * nN; G = G_; c = c_; }
    __host__ __device__ bool next(int i, Unit& u) const {
        const long L = (long)i * G + c; if (L >= nwg) return false;
        int wgid = (int)L; { const int q = nwg / NXCD, r = nwg % NXCD, xcd = wgid % NXCD, off = wgid / NXCD; wgid = (xcd < r ? xcd * (q + 1) : r * (q + 1) + (xcd - r) * q) + off; }
        const int nig = WGM * nN, gid = wgid / nig, fm = gid * WGM, gsz = (nM - fm) < WGM ? (nM - fm) : WGM;
        u.pm = fm + ((wgid % nig) % gsz); u.pn = (wgid % nig) / gsz; return true;
    }
    __device__ __forceinline__ void a_ready(const Unit&) const {}
    __device__ __forceinline__ void done(const Unit&) const {}
};

__device__ __forceinline__ unsigned cvt_pk_bf16(float lo, float hi) { unsigned r; asm volatile("v_cvt_pk_bf16_f32 %0, %1, %2" : "=v"(r) : "v"(lo), "v"(hi)); return r; }
typedef float f32x2 __attribute__((ext_vector_type(2)));
template <class Epi, class Sched, bool ALIGN_EPI = false, bool SP2 = false>
__device__ __forceinline__ void gemm_phase(PG8_LAS unsigned char* lds, const Gemm g, const Sched& S, const Epi& E, const int tid_in) {
    const int tid = tid_in, wid = __builtin_amdgcn_readfirstlane(tid >> 6), lane = tid & 63, wr = wid >> 2, wc = wid & 3, fr = lane & 15, fq = lane >> 4;
    const int K = g.K, nt = K / BK;
    unsigned voffA[2], voffB[2];
#pragma unroll
    for (int i = 0; i < 2; ++i) { int R, C; stage_rc(tid * 16 + i * 8192, R, C); const int Rb = Epi::PERM ? ((R & ~31) + perm32(R & 31)) : R;
        voffA[i] = (unsigned)(R * K + C) * 2u; voffB[i] = (unsigned)(Rb * K + C) * 2u; }
    const size_t kstep = (size_t)(BK * 2);
    const size_t hstep = (size_t)HALF * K * 2;
    const size_t tstep = 2 * hstep;
    const unsigned ldsw = (unsigned)wid * 1024u;
    const int aoff = lds_byte(wr * 64 + fr, fq * 8), boff = lds_byte(wc * 32 + fr, fq * 8);
#define PG8_SA(b, h) (((b) * 2 + (h)) * HTB)
#define PG8_SB(b, h) ((4 + (b) * 2 + (h)) * HTB)
#define PG8_STAGE(bufoff, gbase, voff) do { _Pragma("unroll") for (int _i = 0; _i < 2; ++_i) \
        __builtin_amdgcn_global_load_lds((const unsigned*)((const char*)(gbase) + (voff)[_i]), (PG8_LAS unsigned*)(lds + (bufoff) + ldsw + _i * 8192), 16, 0, 0); } while (0)
#define PG8_LDA(dst, b, h) do { _Pragma("unroll") for (int m = 0; m < 4; ++m) _Pragma("unroll") for (int k = 0; k < 2; ++k) dst[m][k] = *(const PG8_LAS bf16x8*)(lds + PG8_SA(b, h) + aoff + m * 2048 + k * 1024); } while (0)
#define PG8_LDB(dst, b, h) do { _Pragma("unroll") for (int n = 0; n < 2; ++n) _Pragma("unroll") for (int k = 0; k < 2; ++k) dst[n][k] = *(const PG8_LAS bf16x8*)(lds + PG8_SB(b, h) + boff + n * 2048 + k * 1024); } while (0)
#define PG8_MMA(ai, bj, At, Bt) do { __builtin_amdgcn_s_setprio(1); _Pragma("unroll") for (int m = 0; m < 4; ++m) _Pragma("unroll") for (int n = 0; n < 2; ++n) _Pragma("unroll") for (int k = 0; k < 2; ++k) \
        acc[ai][bj][m][n] = __builtin_amdgcn_mfma_f32_16x16x32_bf16(Bt[n][k], At[m][k], acc[ai][bj][m][n], 0, 0, 0); __builtin_amdgcn_s_setprio(0); } while (0)
#define PG8_WAIT_V(n) asm volatile("s_waitcnt vmcnt(" #n ")" ::: "memory")
#define PG8_WAIT_L(n) asm volatile("s_waitcnt lgkmcnt(" #n ")" ::: "memory")
#define PG8_BAR __builtin_amdgcn_s_barrier()
#define PG8_SCHED __builtin_amdgcn_sched_barrier(0)
    Unit cur, nxt; int ui = 0;
    if (!S.next(0, cur)) return;
    f32x4 acc[2][2][4][2];
#pragma unroll
    for (int a = 0; a < 2; ++a)
#pragma unroll
        for (int b = 0; b < 2; ++b)
#pragma unroll
            for (int m = 0; m < 4; ++m)
#pragma unroll
                for (int n = 0; n < 2; ++n) acc[a][b][m][n] = (f32x4){0.f, 0.f, 0.f, 0.f};
    bf16x8 At[4][2], B0[2][2], B1[2][2];
    const char* cA = (const char*)g.A + (size_t)cur.pm * tstep; const char* cB = (const char*)g.Bt + (size_t)cur.pn * tstep;
    S.a_ready(cur);
    if constexpr (SP2) {
        PG8_STAGE(PG8_SB(0, 0), cB, voffB); PG8_STAGE(PG8_SB(0, 1), cB + hstep, voffB); PG8_STAGE(PG8_SA(0, 0), cA, voffA); PG8_STAGE(PG8_SA(0, 1), cA + hstep, voffA);
        if (wr == 1) PG8_BAR;
        PG8_WAIT_V(2); PG8_BAR;
        PG8_STAGE(PG8_SB(1, 0), cB + kstep, voffB); PG8_STAGE(PG8_SA(1, 0), cA + kstep, voffA); PG8_STAGE(PG8_SB(1, 1), cB + hstep + kstep, voffB);
        PG8_WAIT_V(6); PG8_BAR;
    } else {
        PG8_STAGE(PG8_SB(0, 0), cB, voffB); PG8_STAGE(PG8_SA(0, 0), cA, voffA); PG8_STAGE(PG8_SB(0, 1), cB + hstep, voffB); PG8_STAGE(PG8_SA(0, 1), cA + hstep, voffA);
        if (wr == 1) PG8_BAR;
        PG8_WAIT_V(4); PG8_BAR;
        PG8_STAGE(PG8_SB(1, 0), cB + kstep, voffB); PG8_STAGE(PG8_SA(1, 0), cA + kstep, voffA); PG8_STAGE(PG8_SB(1, 1), cB + hstep + kstep, voffB);
        PG8_WAIT_V(6); PG8_BAR;
    }
    for (;;) {
        const bool has_next = S.next(ui + 1, nxt);
        const char* nA = has_next ? (const char*)g.A + (size_t)nxt.pm * tstep : cA; const char* nB = has_next ? (const char*)g.Bt + (size_t)nxt.pn * tstep : cB;
        for (int t = 0; t < nt; t += 2) {
            const bool last = (t == nt - 2);
            const char* a1 = cA + (size_t)(t + 1) * kstep;
            const char* a2 = last ? nA : cA + (size_t)(t + 2) * kstep; const char* b2 = last ? nB : cB + (size_t)(t + 2) * kstep;
            const char* a3 = a2 + kstep; const char* b3 = b2 + kstep;
            if (last && has_next) S.a_ready(nxt);
            if constexpr (SP2) {
            PG8_LDB(B0, 0, 0); PG8_LDB(B1, 0, 1); PG8_SCHED; PG8_LDA(At, 0, 0); PG8_STAGE(PG8_SA(1, 1), a1 + hstep, voffA);
            PG8_WAIT_V(8); PG8_WAIT_L(0); PG8_BAR; PG8_MMA(0, 0, At, B0); PG8_MMA(0, 1, At, B1); PG8_BAR; PG8_SCHED;
            PG8_LDA(At, 0, 1); PG8_STAGE(PG8_SB(0, 0), b2, voffB); PG8_STAGE(PG8_SB(0, 1), b2 + hstep, voffB); PG8_STAGE(PG8_SA(0, 0), a2, voffA);
            PG8_WAIT_V(8); PG8_WAIT_L(0); PG8_BAR; PG8_MMA(1, 0, At, B0); PG8_MMA(1, 1, At, B1); PG8_BAR; PG8_SCHED;
            PG8_LDB(B0, 1, 0); PG8_LDB(B1, 1, 1); PG8_SCHED; PG8_LDA(At, 1, 0); PG8_STAGE(PG8_SA(0, 1), a2 + hstep, voffA);
            PG8_WAIT_V(8); PG8_WAIT_L(0); PG8_BAR; PG8_MMA(0, 0, At, B0); PG8_MMA(0, 1, At, B1); PG8_BAR; PG8_SCHED;
            PG8_LDA(At, 1, 1); PG8_STAGE(PG8_SB(1, 0), b3, voffB); PG8_STAGE(PG8_SB(1, 1), b3 + hstep, voffB); PG8_STAGE(PG8_SA(1, 0), a3, voffA);
            PG8_WAIT_V(8); PG8_WAIT_L(0); PG8_BAR; PG8_MMA(1, 0, At, B0); PG8_MMA(1, 1, At, B1); PG8_BAR; PG8_SCHED;
            } else {
            PG8_LDB(B0, 0, 0); PG8_SCHED; PG8_LDA(At, 0, 0); PG8_STAGE(PG8_SA(1, 1), a1 + hstep, voffA);
            PG8_WAIT_L(8); PG8_BAR; PG8_WAIT_L(0); PG8_MMA(0, 0, At, B0); PG8_BAR; PG8_SCHED;
            PG8_LDB(B1, 0, 1); PG8_STAGE(PG8_SB(0, 0), b2, voffB);
            PG8_BAR; PG8_WAIT_L(0); PG8_MMA(0, 1, At, B1); PG8_BAR;
            PG8_LDA(At, 0, 1); PG8_STAGE(PG8_SA(0, 0), a2, voffA);
            PG8_BAR; PG8_WAIT_L(0); PG8_MMA(1, 0, At, B0); PG8_BAR; PG8_SCHED;
            PG8_STAGE(PG8_SB(0, 1), b2 + hstep, voffB);
            PG8_WAIT_V(6); PG8_BAR; PG8_MMA(1, 1, At, B1); PG8_BAR;
            PG8_LDB(B0, 1, 0); PG8_SCHED; PG8_LDA(At, 1, 0); PG8_STAGE(PG8_SA(0, 1), a2 + hstep, voffA);
            PG8_WAIT_L(8); PG8_BAR; PG8_WAIT_L(0); PG8_MMA(0, 0, At, B0); PG8_BAR; PG8_SCHED;
            PG8_LDB(B1, 1, 1); PG8_STAGE(PG8_SB(1, 0), b3, voffB);
            PG8_BAR; PG8_WAIT_L(0); PG8_MMA(0, 1, At, B1); PG8_BAR;
            PG8_LDA(At, 1, 1); PG8_STAGE(PG8_SA(1, 0), a3, voffA);
            PG8_BAR; PG8_WAIT_L(0); PG8_MMA(1, 0, At, B0); PG8_BAR; PG8_SCHED;
            PG8_STAGE(PG8_SB(1, 1), b3 + hstep, voffB);
            PG8_WAIT_V(6); PG8_BAR; PG8_MMA(1, 1, At, B1); PG8_BAR;
            }
        }
        if constexpr (ALIGN_EPI) { if (wr == 0) PG8_BAR; }
        if constexpr (!Epi::AFTER_DRAIN) { E(acc, cur, wr, wc, fr, fq); S.done(cur); }
        if (!has_next) break;
#pragma unroll
        for (int a = 0; a < 2; ++a)
#pragma unroll
            for (int b = 0; b < 2; ++b)
#pragma unroll
                for (int m = 0; m < 4; ++m)
#pragma unroll
                    for (int n = 0; n < 2; ++n) acc[a][b][m][n] = (f32x4){0.f, 0.f, 0.f, 0.f};
        cur = nxt; cA = nA; cB = nB; ++ui;
        if constexpr (ALIGN_EPI) { if (wr == 1) PG8_BAR; }
    }
    PG8_WAIT_V(0);
    if constexpr (!ALIGN_EPI) { if (wr == 0) PG8_BAR; }
    PG8_BAR;
    if constexpr (Epi::AFTER_DRAIN) { E.fused(acc, cur, wr, wc, fr, fq, lds, wid, lane); S.done(cur); }
#undef PG8_SA
#undef PG8_SB
#undef PG8_STAGE
#undef PG8_LDA
#undef PG8_LDB
#undef PG8_MMA
#undef PG8_WAIT_V
#undef PG8_WAIT_L
#undef PG8_BAR
#undef PG8_SCHED
}
}
#define GAS __attribute__((address_space(1)))
#define LAS __attribute__((address_space(3)))
typedef unsigned short bf16;
typedef unsigned v4u __attribute__((ext_vector_type(4)));
typedef float f32x4 __attribute__((ext_vector_type(4)));
typedef short bf16x8 __attribute__((ext_vector_type(8)));
typedef GAS unsigned gu32;
typedef GAS unsigned long long gu64;
#define RLX_AGENT __ATOMIC_RELAXED, __HIP_MEMORY_SCOPE_AGENT
#define LDS_WAIT() asm volatile("s_waitcnt lgkmcnt(0)" ::: "memory")
#define VM_WAIT() asm volatile("s_waitcnt vmcnt(0)" ::: "memory")
__device__ __forceinline__ unsigned long long rt() { return __builtin_amdgcn_s_memrealtime(); }
__device__ __forceinline__ unsigned f2bf(float f) { unsigned u = __builtin_bit_cast(unsigned, f); return (u + 0x7fffu + ((u >> 16) & 1u)) >> 16; }
__device__ __forceinline__ unsigned pk2(float lo, float hi) { return f2bf(lo) | (f2bf(hi) << 16); }
#define XB_TMO      128
#define XB_XCNT(j)  (256  + 64 * (j))
#define XB_XSUB(j)  (1280 + 64 * (j))
#define XB_XGEN(j)  (2304 + 64 * (j))
#define XB_TOP      3328
#define XB_TOPGEN   3392
#define XCD_BAR_WORDS 3456
#define XB_SPIN_CAP (1u << 18)

__device__ __forceinline__ unsigned xb_ld(unsigned* p)              { return __hip_atomic_load(p, __ATOMIC_RELAXED, __HIP_MEMORY_SCOPE_AGENT); }
__device__ __forceinline__ unsigned xb_add(unsigned* p, unsigned v) { return __hip_atomic_fetch_add(p, v, __ATOMIC_RELAXED, __HIP_MEMORY_SCOPE_AGENT); }
__device__ __forceinline__ unsigned xb_xcc_id() { return (unsigned)__builtin_amdgcn_s_getreg((3 << 11) | 20) & 0xFu; }
#define XB_SPIN(cond, bar) do { unsigned _sp = 0; while (cond) { __builtin_amdgcn_s_sleep(1); \
    if ((++_sp & 255u) == 0u) { if (xb_ld(&(bar)[XB_TMO])) break; if (_sp > XB_SPIN_CAP) { atomicAdd(&(bar)[XB_TMO], 1u); break; } } } } while (0)

struct XcdBarrier {
    unsigned* bar; unsigned x;
    volatile LAS unsigned* st;
};

__device__ __forceinline__ XcdBarrier xcd_barrier_post(unsigned* bar, volatile LAS unsigned* st, bool leader) {
    XcdBarrier b; b.bar = bar; b.x = xb_xcc_id(); b.st = st;
    if (leader) (void)xb_add(&bar[XB_XCNT(b.x)], 1u);
    return b;
}
__device__ __forceinline__ void xcd_barrier_complete(unsigned* bar, unsigned x, unsigned& nloc, unsigned& nx) {
    const unsigned G = gridDim.x * gridDim.y * gridDim.z;
    unsigned sum, cnt, mine, sp = 0u;
    for (;;) {
        sum = 0u; cnt = 0u; mine = 0u;
#pragma unroll
        for (unsigned j = 0; j < 16; ++j) { const unsigned c = xb_ld(&bar[XB_XCNT(j)]); sum += c; cnt += (c > 0u) ? 1u : 0u; mine = (j == x) ? c : mine; }
        if (sum == G) break;
        __builtin_amdgcn_s_sleep(1);
        if ((++sp & 255u) == 0u) { if (xb_ld(&bar[XB_TMO])) break; if (sp > XB_SPIN_CAP) { atomicAdd(&bar[XB_TMO], 1u); break; } }
    }
    nloc = mine > 0u ? mine : 1u; nx = cnt > 0u ? cnt : 1u;
}

__device__ __forceinline__ void xcd_barrier(const XcdBarrier& b, bool leader) {
    asm volatile("s_waitcnt vmcnt(0)" ::: "memory");
    __syncthreads();
    if (leader) {
        unsigned* bar = b.bar;
        __builtin_amdgcn_s_waitcnt(0);
        unsigned nloc = b.st[0], nx = b.st[1];
        if (nloc == 0u) { xcd_barrier_complete(bar, b.x, nloc, nx); b.st[0] = nloc; b.st[1] = nx; }
        const unsigned old = xb_add(&bar[XB_XSUB(b.x)], 1u);
        const unsigned gen = old / nloc;
        if (old + 1u == (gen + 1u) * nloc) {
            __builtin_amdgcn_fence(__ATOMIC_RELEASE, "agent");
            asm volatile("s_waitcnt vmcnt(0)" ::: "memory");
            const unsigned og = xb_add(&bar[XB_TOP], 1u);
            const unsigned tg = og / nx;
            if (og + 1u == (tg + 1u) * nx) xb_add(&bar[XB_TOPGEN], 1u);
            else XB_SPIN(xb_ld(&bar[XB_TOPGEN]) == tg, bar);
            __builtin_amdgcn_fence(__ATOMIC_ACQUIRE, "agent");
            xb_add(&bar[XB_XGEN(b.x)], 1u);
            asm volatile("s_waitcnt vmcnt(0)" ::: "memory");
        } else {
            XB_SPIN(xb_ld(&bar[XB_XGEN(b.x)]) == gen, bar);
            __builtin_amdgcn_fence(__ATOMIC_ACQUIRE, "agent");
            asm volatile("s_waitcnt vmcnt(0)" ::: "memory");
        }
    }
    __syncthreads();
}
namespace fk {
using pg8::bf16_t; using pg8::f32x4; using pg8::bf16x8; using pg8::u32x4; using pg8::Unit; using pg8::cvt_pk_bf16;
typedef float f32x16 __attribute__((ext_vector_type(16)));
typedef unsigned u32x2 __attribute__((ext_vector_type(2)));
typedef float f32x2 __attribute__((ext_vector_type(2)));
#define FLAS __attribute__((address_space(3)))

constexpr int D = 1024, NB = 8, T = 2048, MP = 16384, MS = 128, R = 16512, MT = 16640, FF = 2816, NMEM = 256;
constexpr float EPS = 1e-6f;
constexpr float QSCALE = 0.0625f * 1.4426950408889634f;
constexpr int NWAVES = 8, NTHR = 512;
constexpr int S5L = 128, S5NC = T / S5L;

constexpr size_t MiB = 1u << 20;
constexpr size_t WS_CTL = 0, CTL_ZERO_BYTES = 1 * MiB;
constexpr size_t WS_LAM = 1 * MiB;
constexpr size_t WS_LAMP = WS_LAM + 32768;
constexpr size_t WS_BB = WS_LAMP + 32768;
constexpr size_t WS_CP = WS_BB + 262144;
constexpr size_t WS_LB = WS_CP + 327680;
constexpr size_t WS_SSQ = 3 * MiB;
constexpr size_t WS_SSQS = WS_SSQ + (size_t)MT * 32 * 4;
constexpr size_t WS_E = 6 * MiB;
constexpr size_t WS_BT = 10 * MiB;
constexpr size_t WS_DBG = 11 * MiB;
constexpr size_t WS_W1IN = 12 * MiB, W1IN_SZ = (size_t)2 * FF * D * 2;
constexpr size_t WS_W1OUT = 34 * MiB, W1OUT_SZ = (size_t)D * FF * 2;
constexpr size_t WS_W2IN = 45 * MiB, WS_W2OUT = 67 * MiB;
constexpr size_t WS_WQ = 78 * MiB, WS_WO = 82 * MiB, WQ_SZ = (size_t)D * D * 2;
constexpr size_t WS_WKV = 86 * MiB, WS_WGLU = 94 * MiB, WS_WHGIN = 98 * MiB, WS_WHGOUT = 106 * MiB;
constexpr size_t WS_MEMN = 108 * MiB, WS_KBM = 112 * MiB, WS_VTM = 120 * MiB;
constexpr size_t WS_X = 128 * MiB, WS_XB = 193 * MiB, WS_AB = 226 * MiB, WS_QB = 259 * MiB, WS_GH = 292 * MiB;
constexpr size_t WS_VT = 325 * MiB  , WS_LOGF = 358 * MiB, WS_SST = 423 * MiB, WS_HB = 487 * MiB, WS_SLOC = 487 * MiB;
constexpr size_t WS_FAST_END = 615 * MiB;
static_assert(WS_W1IN + 2 * W1IN_SZ <= WS_W1OUT && WS_W1OUT + 2 * W1OUT_SZ <= WS_W2IN && WS_W2IN + 2 * W1IN_SZ <= WS_W2OUT && WS_W2OUT + 2 * W1OUT_SZ <= WS_WQ, "ws map");
static_assert(WS_X + (size_t)MT * D * 4 <= WS_XB && WS_XB + (size_t)MT * D * 2 <= WS_AB && WS_HB + (size_t)MT * FF * 2 <= WS_FAST_END && WS_SLOC + (size_t)2048 * 16384 * 4 <= WS_FAST_END, "ws map 2");
static_assert(WS_LOGF + (size_t)MT * D * 4 <= WS_SST && WS_SST + (size_t)2048 * 16384 * 2 <= WS_HB && WS_SSQS + 128 * 64 * 4 <= WS_E, "ws map 3");
constexpr size_t O_Y = 0, O_S5RE_P = (size_t)R * D, O_S5IM_P = O_S5RE_P + 32768, O_S5RE_S = O_S5IM_P + 32768, O_S5IM_S = O_S5RE_S + 524288,
                 O_HG_P = O_S5IM_S + 524288, O_HG_S = O_HG_P + 1048576, O_MK = O_HG_S + 16777216, O_MV = O_MK + 4194304, O_END = O_MV + 4194304;
static_assert(O_END == 44236800, "out size");

constexpr int RING_BYTES = 131072, LDSCTL_OFF = RING_BYTES, MISC_OFF = LDSCTL_OFF + 320, LDS_BYTES = 147456;

__device__ __forceinline__ float fast_exp(float x) { return __builtin_amdgcn_exp2f(x * 1.4426950408889634f); }
__device__ __forceinline__ float fast_rcp(float x) { return __builtin_amdgcn_rcpf(x); }
__device__ __forceinline__ float silu_f(float x) { return x * fast_rcp(1.0f + fast_exp(-x)); }
__device__ __forceinline__ float sigm_f(float x) { return fast_rcp(1.0f + fast_exp(-x)); }
__device__ __forceinline__ unsigned f2bf(float f) { unsigned u = __builtin_bit_cast(unsigned, f); return (u + 0x7fffu + ((u >> 16) & 1u)) >> 16; }
__device__ __forceinline__ unsigned pk2(float lo, float hi) { return cvt_pk_bf16(lo, hi); }
__device__ __forceinline__ float bf2f(unsigned short b) { return __builtin_bit_cast(float, (unsigned)b << 16); }
__device__ __forceinline__ float bflo(unsigned w) { return __builtin_bit_cast(float, w << 16); }
__device__ __forceinline__ float bfhi(unsigned w) { return __builtin_bit_cast(float, w & 0xffff0000u); }
__device__ __forceinline__ float wave_sum(float v) {
#pragma unroll
    for (int o = 1; o < 64; o <<= 1) v += __shfl_xor(v, o);
    return v;
}
template <int NP> __device__ __forceinline__ float row_rstd(const float* __restrict__ ssq, int row) {
    const f32x4* p = (const f32x4*)(ssq + (size_t)row * 32); float s = 0.f;
#pragma unroll
    for (int i = 0; i < NP / 4; ++i) { const f32x4 v = p[i]; s += (v[0] + v[1]) + (v[2] + v[3]); }
    return 1.0f / sqrtf(s * (1.0f / D) + EPS);
}

template <int NP> __device__ __forceinline__ void tile_rstd8(const float* __restrict__ ssq, int pm, int wr, int fr, int fq, float (&rs)[2][4]) {
    f32x4 p[2][4][NP / 16];
#pragma unroll
    for (int ai = 0; ai < 2; ++ai)
#pragma unroll
        for (int m = 0; m < 4; ++m)
#pragma unroll
            for (int j = 0; j < NP / 16; ++j) p[ai][m][j] = *(const f32x4*)(ssq + (size_t)(pm * 256 + ai * 128 + wr * 64 + m * 16 + fr) * 32 + 4 * fq + 16 * j);
    __builtin_amdgcn_sched_barrier(0);
#pragma unroll
    for (int ai = 0; ai < 2; ++ai)
#pragma unroll
        for (int m = 0; m < 4; ++m) { float a = 0.f;
#pragma unroll
            for (int j = 0; j < NP / 16; ++j) a += (p[ai][m][j][0] + p[ai][m][j][1]) + (p[ai][m][j][2] + p[ai][m][j][3]);
            a += __shfl_xor(a, 16); a += __shfl_xor(a, 32);
            rs[ai][m] = 1.0f / sqrtf(a * (1.0f / D) + EPS); }
}
#define EPI_ROWS_BEGIN  _Pragma("unroll") for (int ai = 0; ai < 2; ++ai) _Pragma("unroll") for (int m = 0; m < 4; ++m) { const int row = u.pm * 256 + ai * 128 + wr * 64 + m * 16 + fr;
#define EPI_ROWS_END    }

template <int NP> struct EpiSwiglu {
    static constexpr bool PERM = true, AFTER_DRAIN = false;
    const float* ssq; bf16_t* H;
    __device__ __forceinline__ void operator()(const f32x4 (&acc)[2][2][4][2], const Unit& u, int wr, int wc, int fr, int fq) const {
        const int col0 = u.pn * 128 + wc * 32 + 8 * fq;
        float rsv[2][4]; tile_rstd8<NP>(ssq, u.pm, wr, fr, fq, rsv);
        EPI_ROWS_BEGIN
            const float rs = rsv[ai][m];
            float h[8];
#pragma unroll
            for (int n = 0; n < 2; ++n)
#pragma unroll
                for (int i = 0; i < 4; ++i) { const float g = acc[ai][0][m][n][i] * rs, up = acc[ai][1][m][n][i] * rs; h[4 * n + i] = silu_f(g) * up; }
            u32x4 w; w.x = pk2(h[0], h[1]); w.y = pk2(h[2], h[3]); w.z = pk2(h[4], h[5]); w.w = pk2(h[6], h[7]);
            *(u32x4*)(H + (size_t)row * FF + col0) = w;
        EPI_ROWS_END
    }
};
__device__ __forceinline__ void bf8_to_f32(const u32x4 w, f32x4& lo, f32x4& hi) { lo = (f32x4){bflo(w.x), bfhi(w.x), bflo(w.y), bfhi(w.y)}; hi = (f32x4){bflo(w.z), bfhi(w.z), bflo(w.w), bfhi(w.w)}; }
struct EpiResid {
    static constexpr bool PERM = true, AFTER_DRAIN = false;
    bf16_t* XB; float* ssq; float scale;
    __device__ __forceinline__ void operator()(const f32x4 (&acc)[2][2][4][2], const Unit& u, int wr, int wc, int fr, int fq) const {
#pragma unroll
        for (int ai = 0; ai < 2; ++ai) {
            u32x4 xv[4][2];
#pragma unroll
            for (int m = 0; m < 4; ++m)
#pragma unroll
                for (int bj = 0; bj < 2; ++bj) xv[m][bj] = *(const u32x4*)(XB + (size_t)(u.pm * 256 + ai * 128 + wr * 64 + m * 16 + fr) * D + u.pn * 256 + bj * 128 + wc * 32 + 8 * fq);
            __builtin_amdgcn_sched_barrier(0);
#pragma unroll
            for (int m = 0; m < 4; ++m) { const int row = u.pm * 256 + ai * 128 + wr * 64 + m * 16 + fr;
                float sq = 0.f;
#pragma unroll
                for (int bj = 0; bj < 2; ++bj) {
                    const size_t off = (size_t)row * D + u.pn * 256 + bj * 128 + wc * 32 + 8 * fq;
                    f32x4 x0, x1; bf8_to_f32(xv[m][bj], x0, x1);
                    x0 = x0 + acc[ai][bj][m][0] * scale; x1 = x1 + acc[ai][bj][m][1] * scale;
                    u32x4 w; w.x = pk2(x0[0], x0[1]); w.y = pk2(x0[2], x0[3]); w.z = pk2(x1[0], x1[1]); w.w = pk2(x1[2], x1[3]);
                    *(u32x4*)(XB + off) = w;
                    bf8_to_f32(w, x0, x1);
                    sq += (x0[0] * x0[0] + x0[1] * x0[1]) + (x0[2] * x0[2] + x0[3] * x0[3]) + (x1[0] * x1[0] + x1[1] * x1[1]) + (x1[2] * x1[2] + x1[3] * x1[3]);
                }
                sq += __shfl_xor(sq, 16); sq += __shfl_xor(sq, 32);
                if (fq == 0) ssq[(size_t)row * 32 + u.pn * 4 + wc] = sq; }
            __builtin_amdgcn_sched_barrier(0);
        }
    }
};
struct EpiGlu {
    static constexpr bool PERM = true, AFTER_DRAIN = false;
    bf16_t* XB; float* ssq;
    __device__ __forceinline__ void operator()(const f32x4 (&acc)[2][2][4][2], const Unit& u, int wr, int wc, int fr, int fq) const {
        u32x4 xv[2][4];
#pragma unroll
        for (int ai = 0; ai < 2; ++ai)
#pragma unroll
            for (int m = 0; m < 4; ++m) xv[ai][m] = *(const u32x4*)(XB + (size_t)(u.pm * 256 + ai * 128 + wr * 64 + m * 16 + fr) * D + u.pn * 128 + wc * 32 + 8 * fq);
        __builtin_amdgcn_sched_barrier(0);
        EPI_ROWS_BEGIN
            const size_t off = (size_t)row * D + u.pn * 128 + wc * 32 + 8 * fq;
            f32x4 x0, x1; bf8_to_f32(xv[ai][m], x0, x1);
#pragma unroll
            for (int i = 0; i < 4; ++i) { x0[i] += acc[ai][0][m][0][i] * sigm_f(acc[ai][1][m][0][i]); x1[i] += acc[ai][0][m][1][i] * sigm_f(acc[ai][1][m][1][i]); }
            u32x4 w; w.x = pk2(x0[0], x0[1]); w.y = pk2(x0[2], x0[3]); w.z = pk2(x1[0], x1[1]); w.w = pk2(x1[2], x1[3]);
            *(u32x4*)(XB + off) = w;
            bf8_to_f32(w, x0, x1);
            float sq = (x0[0] * x0[0] + x0[1] * x0[1]) + (x0[2] * x0[2] + x0[3] * x0[3]) + (x1[0] * x1[0] + x1[1] * x1[1]) + (x1[2] * x1[2] + x1[3] * x1[3]);
            sq += __shfl_xor(sq, 16); sq += __shfl_xor(sq, 32);
            if (fq == 0) ssq[(size_t)row * 32 + u.pn * 4 + wc] = sq;
        EPI_ROWS_END
    }
};
template <int NP> struct EpiQ {
    static constexpr bool PERM = true, AFTER_DRAIN = false;
    const float* ssq; bf16_t* Q;
    __device__ __forceinline__ void operator()(const f32x4 (&acc)[2][2][4][2], const Unit& u, int wr, int wc, int fr, int fq) const {
        float rsv[2][4]; tile_rstd8<NP>(ssq, u.pm, wr, fr, fq, rsv);
        EPI_ROWS_BEGIN
            const float rs = rsv[ai][m] * QSCALE;
#pragma unroll
            for (int bj = 0; bj < 2; ++bj) {
                const size_t off = (size_t)row * D + u.pn * 256 + bj * 128 + wc * 32 + 8 * fq;
                const f32x4 a = acc[ai][bj][m][0] * rs, b = acc[ai][bj][m][1] * rs;
                u32x4 w; w.x = pk2(a[0], a[1]); w.y = pk2(a[2], a[3]); w.z = pk2(b[0], b[1]); w.w = pk2(b[2], b[3]);
                *(u32x4*)(Q + off) = w;
            }
        EPI_ROWS_END
    }
};
__device__ __forceinline__ int perm16pos(int m) { return (m & ~12) | ((m & 4) << 1) | ((m & 8) >> 1); }
struct EpiMemKV {
    static constexpr bool PERM = true, AFTER_DRAIN = false;
    float* out; bf16_t* KB; bf16_t* VT;
    __device__ __forceinline__ void operator()(const f32x4 (&acc)[2][2][4][2], const Unit& u, int wr, int wc, int fr, int fq) const {
        const int layer = u.pn >> 3, kv = (u.pn >> 2) & 1, jt = (u.pn & 3) * 256;
        EPI_ROWS_BEGIN
#pragma unroll
            for (int bj = 0; bj < 2; ++bj) {
                const int j = jt + bj * 128 + wc * 32 + 8 * fq;
                const f32x4 a = acc[ai][bj][m][0], b = acc[ai][bj][m][1];
                float* o = out + (kv ? O_MV : O_MK) + ((size_t)layer * 2048 + row) * D + j;
                *(f32x4*)o = a; *(f32x4*)(o + 4) = b;
                if (kv == 0) { u32x4 w; w.x = pk2(a[0], a[1]); w.y = pk2(a[2], a[3]); w.z = pk2(b[0], b[1]); w.w = pk2(b[2], b[3]);
                    *(u32x4*)(KB + ((size_t)layer * 2048 + row) * D + j) = w; }
                else {
                    const int bb = row >> 8, mm = row & 255, hh = j >> 8, dv = j & 255;
                    bf16_t* vt = VT + ((((size_t)layer * 8 + bb) * 4 + hh) * 256 + dv) * 256 + perm16pos(mm);
#pragma unroll
                    for (int i = 0; i < 4; ++i) { vt[(size_t)i * 256] = (bf16_t)f2bf(a[i]); vt[(size_t)(4 + i) * 256] = (bf16_t)f2bf(b[i]); }
                }
            }
        EPI_ROWS_END
    }
};
template <int NP> struct EpiHgIn {
    static constexpr bool PERM = true, AFTER_DRAIN = false;
    const float* ssq; const float* lb; bf16_t* QH; float* LOGF; bf16_t* VN; bf16_t* GH;
    __device__ __forceinline__ void operator()(const f32x4 (&acc)[2][2][4][2], const Unit& u, int wr, int wc, int fr, int fq) const {
        const int sec = u.pn >> 2, jt = (u.pn & 3) * 256;
        float rsv[2][4]; tile_rstd8<NP>(ssq, u.pm, wr, fr, fq, rsv);
        EPI_ROWS_BEGIN
            const float rs = rsv[ai][m];
#pragma unroll
            for (int bj = 0; bj < 2; ++bj) {
                const int j = jt + bj * 128 + wc * 32 + 8 * fq;
                const f32x4 a = acc[ai][bj][m][0] * rs, b = acc[ai][bj][m][1] * rs;
                if (sec == 1) {
                    const f32x4 l0 = *(const f32x4*)(lb + j), l1 = *(const f32x4*)(lb + j + 4);
                    f32x4 o0, o1;
#pragma unroll
                    for (int i = 0; i < 4; ++i) { const float k0 = (1.0f - l0[i]) * fast_rcp(1.0f + fast_exp(a[i])), k1 = (1.0f - l1[i]) * fast_rcp(1.0f + fast_exp(b[i]));
                        o0[i] = __builtin_amdgcn_logf(1.0f - k0) * 0.6931471805599453f; o1[i] = __builtin_amdgcn_logf(1.0f - k1) * 0.6931471805599453f; }
                    *(f32x4*)(LOGF + (size_t)row * D + j) = o0; *(f32x4*)(LOGF + (size_t)row * D + j + 4) = o1;
                } else {
                    float s[8];
#pragma unroll
                    for (int i = 0; i < 4; ++i) { s[i] = sec == 2 ? a[i] : silu_f(a[i]); s[4 + i] = sec == 2 ? b[i] : silu_f(b[i]); }
                    u32x4 w; w.x = pk2(s[0], s[1]); w.y = pk2(s[2], s[3]); w.z = pk2(s[4], s[5]); w.w = pk2(s[6], s[7]);
                    const size_t off = (size_t)row * D + j;
                    if (sec == 0) *(u32x4*)(QH + off) = w; else if (sec == 2) *(u32x4*)(VN + off) = w; else *(u32x4*)(GH + off) = w;
                }
            }
        EPI_ROWS_END
    }
};

__device__ __forceinline__ float srow_rstd(const float* __restrict__ ssqs, int srow) {
    const f32x4* p = (const f32x4*)(ssqs + (size_t)srow * 64); float s = 0.f;
#pragma unroll
    for (int i = 0; i < 16; ++i) { const f32x4 v = p[i]; s += (v[0] + v[1]) + (v[2] + v[3]); }
    return 1.0f / sqrtf(s * (1.0f / D) + EPS);
}
__device__ __forceinline__ void srow_rstd4(const float* __restrict__ ssqs, int srow0, int cl, float (&rs)[4]) {
#pragma unroll
    for (int j = 0; j < 4; ++j) { const f32x4 v = *(const f32x4*)(ssqs + (size_t)(srow0 + j) * 64 + 4 * cl); float s = (v[0] + v[1]) + (v[2] + v[3]);
        s += __shfl_xor(s, 1); s += __shfl_xor(s, 2); s += __shfl_xor(s, 4); s += __shfl_xor(s, 8); rs[j] = 1.0f / sqrtf(s * (1.0f / D) + EPS); }
}
template <bool PAIRED, int KS, int NT, class SEpi>
__device__ __forceinline__ void skinny_unit(const bf16_t* __restrict__ A, const bf16_t* __restrict__ Bt, int u, int wave, int lane, FLAS unsigned char* lds, const SEpi& E) {
    constexpr int K = KS * 128, NB_ = PAIRED ? 2 : 1, NACC = NT * NB_, CH = (KS == 8) ? ((NACC >= 4) ? 4 : 8) : 11, NCH = KS / CH;
    static_assert(KS % CH == 0, "chunking");
    const int cl = lane & 15, kq = lane >> 4, rt = wave & 1, kw = wave >> 1, rb = u & 3, uc = u >> 2;
    const int srow = 32 * rb + 16 * rt;
    const bf16_t* ap = A + (size_t)(MP + srow + cl) * K + kw * (KS * 32) + 8 * kq;
    const bf16_t* bp[NACC];
#pragma unroll
    for (int t = 0; t < NT; ++t) { const int c = 16 * (NT * uc + t) + cl;
        if (PAIRED) { const int rw = (c >> 7) * 256 + (c & 127); bp[2 * t] = Bt + (size_t)rw * K + kw * (KS * 32) + 8 * kq; bp[2 * t + 1] = bp[2 * t] + (size_t)128 * K; }
        else bp[t] = Bt + (size_t)c * K + kw * (KS * 32) + 8 * kq; }
    f32x4 acc[NACC];
#pragma unroll
    for (int i = 0; i < NACC; ++i) acc[i] = (f32x4){0.f, 0.f, 0.f, 0.f};
#pragma unroll
    for (int chn = 0; chn < NCH; ++chn) {
        bf16x8 a[CH], b[NACC][CH];
#pragma unroll
        for (int i = 0; i < CH; ++i) { a[i] = *(const bf16x8*)(ap + 32 * (chn * CH + i));
#pragma unroll
            for (int j = 0; j < NACC; ++j) b[j][i] = *(const bf16x8*)(bp[j] + 32 * (chn * CH + i)); }
        __builtin_amdgcn_sched_barrier(0);
#pragma unroll
        for (int i = 0; i < CH; ++i)
#pragma unroll
            for (int j = 0; j < NACC; ++j) acc[j] = __builtin_amdgcn_mfma_f32_16x16x32_bf16(a[i], b[j][i], acc[j], 0, 0, 0);
        __builtin_amdgcn_sched_barrier(0);
    }
    FLAS f32x4* red = (FLAS f32x4*)lds;
#pragma unroll
    for (int j = 0; j < NACC; ++j) red[(wave * NACC + j) * 64 + lane] = acc[j];
    asm volatile("s_waitcnt lgkmcnt(0)" ::: "memory"); __builtin_amdgcn_s_barrier(); asm volatile("" ::: "memory");
    if (kw == 0) {
#pragma unroll
        for (int q = 1; q < 4; ++q)
#pragma unroll
            for (int j = 0; j < NACC; ++j) acc[j] = acc[j] + red[((rt + 2 * q) * NACC + j) * 64 + lane];
#pragma unroll
        for (int t = 0; t < NT; ++t) { const f32x4 pr[2] = {acc[NB_ * t], acc[NB_ * t + (NB_ - 1)]}; E(pr, srow + 4 * kq, 16 * (NT * uc + t) + cl, NT * uc + t, cl); }
    }
    asm volatile("s_waitcnt lgkmcnt(0)" ::: "memory"); __builtin_amdgcn_s_barrier(); asm volatile("" ::: "memory");
}
struct SEpiSwiglu { const float* ssqs; bf16_t* H;
    __device__ __forceinline__ void operator()(const f32x4 (&acc)[2], int srow0, int col, int, int cl) const {
        float rs[4]; srow_rstd4(ssqs, srow0, cl, rs);
#pragma unroll
        for (int j = 0; j < 4; ++j) H[(size_t)(MP + srow0 + j) * FF + col] = (bf16_t)f2bf(silu_f(acc[0][j] * rs[j]) * (acc[1][j] * rs[j])); } };
struct SEpiResid { bf16_t* XB; float* ssqs; float scale;
    __device__ __forceinline__ void operator()(const f32x4 (&acc)[2], int srow0, int col, int u, int cl) const {
#pragma unroll
        for (int j = 0; j < 4; ++j) { const size_t off = (size_t)(MP + srow0 + j) * D + col; const unsigned short xb_ = (unsigned short)f2bf(bf2f(XB[off]) + scale * acc[0][j]); XB[off] = xb_; const float x = bf2f(xb_); float sq = x * x;
            sq += __shfl_xor(sq, 1); sq += __shfl_xor(sq, 2); sq += __shfl_xor(sq, 4); sq += __shfl_xor(sq, 8);
            if (cl == 0) ssqs[(size_t)(srow0 + j) * 64 + u] = sq; } } };
struct SEpiGlu { bf16_t* XB; float* ssqs;
    __device__ __forceinline__ void operator()(const f32x4 (&acc)[2], int srow0, int col, int u, int cl) const {
#pragma unroll
        for (int j = 0; j < 4; ++j) { const size_t off = (size_t)(MP + srow0 + j) * D + col; const unsigned short xb_ = (unsigned short)f2bf(bf2f(XB[off]) + acc[0][j] * sigm_f(acc[1][j])); XB[off] = xb_; const float x = bf2f(xb_); float sq = x * x;
            sq += __shfl_xor(sq, 1); sq += __shfl_xor(sq, 2); sq += __shfl_xor(sq, 4); sq += __shfl_xor(sq, 8);
            if (cl == 0) ssqs[(size_t)(srow0 + j) * 64 + u] = sq; } } };
struct SEpiQ { const float* ssqs; bf16_t* Q;
    __device__ __forceinline__ void operator()(const f32x4 (&acc)[2], int srow0, int col, int, int cl) const {
        float rs[4]; srow_rstd4(ssqs, srow0, cl, rs);
#pragma unroll
        for (int j = 0; j < 4; ++j) Q[(size_t)(MP + srow0 + j) * D + col] = (bf16_t)f2bf(acc[0][j] * rs[j] * QSCALE); } };
struct SEpiHgIn { const float* ssqs; const float* lb; bf16_t* QH; float* LOGF; bf16_t* VN; bf16_t* GH;
    __device__ __forceinline__ void operator()(const f32x4 (&acc)[2], int srow0, int col, int u, int cl) const {
        const int sec = u >> 6, c = col & 1023;
        float rs[4]; srow_rstd4(ssqs, srow0, cl, rs);
#pragma unroll
        for (int j = 0; j < 4; ++j) { const size_t off = (size_t)(MP + srow0 + j) * D + c; const float v = acc[0][j] * rs[j];
            if (sec == 0) QH[off] = (bf16_t)f2bf(silu_f(v));
            else if (sec == 1) { const float kk = (1.0f - lb[c]) * fast_rcp(1.0f + fast_exp(v)); LOGF[off] = __builtin_amdgcn_logf(1.0f - kk) * 0.6931471805599453f; }
            else if (sec == 2) VN[off] = (bf16_t)f2bf(v);
            else GH[off] = (bf16_t)f2bf(silu_f(v)); } } };
struct Args { const float* in[34]; float* out; unsigned char* ws; int ph_lo, ph_hi; };
#define KAS __attribute__((address_space(4)))
struct Frame {
    FLAS unsigned char* lds;
    int tid, lane, wave, vcu, G;
    KAS const char* ka; float* out; unsigned char* ws;
};
static_assert(sizeof(Args) == 296, "Args layout");
#define FIN(i) (*(const float* KAS const*)(F.ka + 8 * (i)))
#define WSP(T_, off) ((T_*)(F.ws + (off)))

__device__ __forceinline__ void prep_transpose_item(const float* __restrict__ W, int K, int N, bf16_t* __restrict__ WT, int mode, int row_off_or_S, const float* __restrict__ gain,
                                                    FLAS float* scr, int item, int lane) {
    const int nblk = N / 32, kb = item / nblk, nb = item % nblk, k0 = 64 * kb, n0 = 32 * nb;
    {   f32x4 v[8]; const int r8 = lane >> 3, c4 = 4 * (lane & 7);
#pragma unroll
        for (int i = 0; i < 8; ++i) v[i] = *(const f32x4*)(W + (size_t)(k0 + 8 * i + r8) * N + n0 + c4);
        __builtin_amdgcn_sched_barrier(0);
#pragma unroll
        for (int i = 0; i < 8; ++i) { const int kk = 8 * i + r8; const float g = gain ? gain[k0 + kk] : 1.0f;
            scr[kk * 33 + c4] = v[i][0] * g; scr[kk * 33 + c4 + 1] = v[i][1] * g; scr[kk * 33 + c4 + 2] = v[i][2] * g; scr[kk * 33 + c4 + 3] = v[i][3] * g; } }
    asm volatile("s_waitcnt lgkmcnt(0)" ::: "memory");
    int d0;
    if (mode == 0) d0 = row_off_or_S + n0;
    else { const int S = row_off_or_S; if (n0 < S) d0 = (n0 >> 7) * 256 + (n0 & 127); else { const int j = n0 - S; d0 = (j >> 7) * 256 + 128 + (j & 127); } }
    const int c = lane & 7;
#pragma unroll
    for (int j = 0; j < 4; ++j) { const int n = (lane >> 3) + 8 * j; const FLAS float* s = scr + (8 * c) * 33 + n;
        u32x4 o; o.x = pk2(s[0 * 33], s[1 * 33]); o.y = pk2(s[2 * 33], s[3 * 33]); o.z = pk2(s[4 * 33], s[5 * 33]); o.w = pk2(s[6 * 33], s[7 * 33]);
        *(u32x4*)(WT + (size_t)(d0 + n) * K + k0 + 8 * c) = o; }
    asm volatile("s_waitcnt lgkmcnt(0)" ::: "memory");
}

__device__ __forceinline__ void phase_prep(Frame& F) {
    FLAS float* scr = (FLAS float*)(F.lds + F.wave * 16384);
    const int gw = F.vcu * NWAVES + F.wave, NGW = F.G * NWAVES, lane = F.lane;
    constexpr int I_IN = 16 * 176, I_OUT = 44 * 32, I_SQ = 16 * 32, I_KV = 16 * 64, I_GLU = 16 * 64, I_HGIN = 16 * 128;
    constexpr int NITEMS = 4 * I_IN + 4 * I_OUT + 4 * I_SQ + 2 * I_KV + I_GLU + I_HGIN + I_SQ;
    for (int it = gw; it < NITEMS; it += NGW) {
        int r = it;
        if (r < 4 * I_IN) { const int w = r / I_IN, l = w & 1, second = w >> 1; r -= w * I_IN;
            prep_transpose_item(FIN(second ? 18 : 9) + (size_t)l * D * 2 * FF, D, 2 * FF, WSP(bf16_t, (second ? WS_W2IN : WS_W1IN) + l * W1IN_SZ), 1, FF, FIN(second ? 17 : 8) + l * D, scr, r, lane); continue; }
        r -= 4 * I_IN;
        if (r < 4 * I_OUT) { const int w = r / I_OUT, l = w & 1, second = w >> 1; r -= w * I_OUT;
            prep_transpose_item(FIN(second ? 19 : 10) + (size_t)l * FF * D, FF, D, WSP(bf16_t, (second ? WS_W2OUT : WS_W1OUT) + l * W1OUT_SZ), 0, 0, nullptr, scr, r, lane); continue; }
        r -= 4 * I_OUT;
        if (r < 2 * I_SQ) { const int l = r / I_SQ; r -= l * I_SQ;
            prep_transpose_item(FIN(14) + (size_t)l * D * D, D, D, WSP(bf16_t, WS_WQ + l * WQ_SZ), 0, 0, FIN(12) + l * D, scr, r, lane); continue; }
        r -= 2 * I_SQ;
        if (r < 2 * I_SQ) { const int l = r / I_SQ; r -= l * I_SQ;
            prep_transpose_item(FIN(16) + (size_t)l * D * D, D, D, WSP(bf16_t, WS_WO + l * WQ_SZ), 0, 0, nullptr, scr, r, lane); continue; }
        r -= 2 * I_SQ;
        if (r < 2 * I_KV) { const int l = r / I_KV; r -= l * I_KV;
            prep_transpose_item(FIN(15) + (size_t)l * D * 2 * D, D, 2 * D, WSP(bf16_t, WS_WKV), 0, l * 2048, FIN(13) + l * D, scr, r, lane); continue; }
        r -= 2 * I_KV;
        if (r < I_GLU) { prep_transpose_item(FIN(28), D, 2 * D, WSP(bf16_t, WS_WGLU), 1, D, nullptr, scr, r, lane); continue; }
        r -= I_GLU;
        if (r < I_HGIN) { prep_transpose_item(FIN(29), D, 4 * D, WSP(bf16_t, WS_WHGIN), 0, 0, FIN(11) + D, scr, r, lane); continue; }
        r -= I_HGIN;
        prep_transpose_item(FIN(32), D, D, WSP(bf16_t, WS_WHGOUT), 0, 0, nullptr, scr, r, lane);
    }
    bf16_t* XB = WSP(bf16_t, WS_XB); float* SSQ = WSP(float, WS_SSQ);
    for (int row = gw; row < MT; row += NGW) {
        f32x4 v[4]; float s = 0.f;
        const float* src = row < MP ? FIN(0) + (size_t)row * D : FIN(1) + (size_t)(row - MP) * D;
#pragma unroll
        for (int j = 0; j < 4; ++j) { v[j] = row < R ? ((const f32x4*)src)[lane + 64 * j] : (f32x4){0.f, 0.f, 0.f, 0.f}; s += (v[j][0] * v[j][0] + v[j][1] * v[j][1]) + (v[j][2] * v[j][2] + v[j][3] * v[j][3]); }
        s = wave_sum(s);
#pragma unroll
        for (int j = 0; j < 4; ++j) { u32x2 w; w.x = pk2(v[j][0], v[j][1]); w.y = pk2(v[j][2], v[j][3]); ((u32x2*)(XB + (size_t)row * D))[lane + 64 * j] = w; }
        if (lane < 32) SSQ[(size_t)row * 32 + lane] = lane == 0 ? s : 0.f;
        if (row >= MP && row < R) WSP(float, WS_SSQS)[(size_t)(row - MP) * 64 + lane] = lane == 0 ? s : 0.f;
    }
    bf16_t* MEMN = WSP(bf16_t, WS_MEMN);
    for (int row = gw; row < NB * NMEM; row += NGW) {
        f32x4 v[4]; float s = 0.f;
#pragma unroll
        for (int j = 0; j < 4; ++j) { v[j] = ((const f32x4*)(FIN(2) + (size_t)row * D))[lane + 64 * j]; s += (v[j][0] * v[j][0] + v[j][1] * v[j][1]) + (v[j][2] * v[j][2] + v[j][3] * v[j][3]); }
        const float rs = 1.0f / sqrtf(wave_sum(s) * (1.0f / D) + EPS);
#pragma unroll
        for (int j = 0; j < 4; ++j) { u32x2 w; w.x = pk2(v[j][0] * rs, v[j][1] * rs); w.y = pk2(v[j][2] * rs, v[j][3] * rs); ((u32x2*)(MEMN + (size_t)row * D))[lane + 64 * j] = w; }
    }
    if (gw < 64) {
        const int g = gw, p = lane, pl = p & 31, ph = p >> 5;
        const double dt = gold::d_exp((double)FIN(22)[g]);
        const double lr = (double)FIN(20)[g * 64 + p], li = (double)FIN(21)[g * 64 + p];
        double sn, cs; gold::d_sincos(li * dt, sn, cs); const double er = gold::d_exp(lr * dt);
        const double lbr = er * cs, lbi = er * sn;
        double sn2, cs2; gold::d_sincos(li * dt * (double)S5L, sn2, cs2); const double er2 = gold::d_exp(lr * dt * (double)S5L);
        WSP(f32x2, WS_LAM)[g * 64 + p] = (f32x2){(float)lbr, (float)lbi};
        WSP(f32x2, WS_LAMP)[g * 64 + p] = (f32x2){(float)(er2 * cs2), (float)(er2 * sn2)};
        const double nr = lbr - 1.0, ni = lbi, den = lr * lr + li * li;
        const double fr = (nr * lr + ni * li) / den, fi = (ni * lr - nr * li) / den;
        bf16_t* BB = WSP(bf16_t, WS_BB); bf16_t* CP = WSP(bf16_t, WS_CP);
        const float* gain = FIN(11);
#pragma unroll
        for (int c = 0; c < 16; ++c) { const double br = FIN(23)[(g * 64 + p) * 16 + c], bi = FIN(24)[(g * 64 + p) * 16 + c], gn = gain[g * 16 + c];
            BB[((g * 4 + ph) * 32 + pl) * 16 + c] = (bf16_t)f2bf((float)((fr * br - fi * bi) * gn));
            BB[((g * 4 + 2 + ph) * 32 + pl) * 16 + c] = (bf16_t)f2bf((float)((fr * bi + fi * br) * gn));
            CP[(g * 16 + c) * 160 + 4 * pl + 2 * ph] = (bf16_t)f2bf(FIN(25)[(g * 16 + c) * 64 + p]);
            CP[(g * 16 + c) * 160 + 4 * pl + 2 * ph + 1] = (bf16_t)f2bf(-FIN(26)[(g * 16 + c) * 64 + p]); }
        if (p < 16) {
            unsigned zz = 0u; asm volatile("" : "+v"(zz));
            const unsigned dval = f2bf(FIN(27)[g * 16 + p] * gain[g * 16 + p]);
            unsigned* cpw = (unsigned*)(CP + (g * 16 + p) * 160 + 128);
#pragma unroll
            for (int c2 = 0; c2 < 16; ++c2) cpw[c2] = (c2 < 8) ? (((2 * c2 == p) ? dval : zz) | ((2 * c2 + 1 == p) ? (dval << 16) : zz)) : zz;
        }
    }
    if (gw >= 64 && gw < 80) { const int i = (gw - 64) * 64 + lane; WSP(float, WS_LB)[i] = 1.0f / (1.0f + expf(-(FIN(30)[1024 + i] - FIN(30)[i]))); }
}

constexpr int S5_RS = 336;
template <int MODE> __device__ __forceinline__ void s5_task(Frame& F, int gb, int sp) {
    const int lane = F.lane, g = gb * 8 + F.wave, col = lane & 31, hi = lane >> 5;
    const bf16_t* XBp = WSP(bf16_t, WS_XB); const float* SSQ = WSP(float, WS_SSQ);
    const bf16_t* BB = WSP(bf16_t, WS_BB); const bf16_t* CP = WSP(bf16_t, WS_CP);
    FLAS unsigned char* hl = F.lds + F.wave * (32 * S5_RS);
    bf16x8 bbf[4];
#pragma unroll
    for (int nb = 0; nb < 4; ++nb) bbf[nb] = *(const bf16x8*)(BB + ((g * 4 + nb) * 32 + col) * 16 + 8 * hi);
    const f32x2 lam0 = WSP(f32x2, WS_LAM)[g * 64 + col], lam1 = WSP(f32x2, WS_LAM)[g * 64 + 32 + col];
    const int rho = lane & 31, hr = (rho >> 2) & 1, tr = (rho & 3) + 4 * (rho >> 3);
    int rowA, rowC0, rowC1;
    int nsteps;
    if (MODE == 2) { rowC0 = MP + sp * 32; rowC1 = rowC0 + 16; nsteps = 1; }
    else { const int s0 = sp, s1 = sp + 64; rowC0 = (s0 >> 4) * T + (s0 & 15) * S5L; rowC1 = (s1 >> 4) * T + (s1 & 15) * S5L; nsteps = S5L / 16; }
    rowA = hr ? rowC1 : rowC0;
    float h0r = 0.f, h0i = 0.f, h1r = 0.f, h1i = 0.f;
    if (MODE == 1) {
        const int s = sp + 64 * hi, c = s & 15;
        const f32x2 lp0 = WSP(f32x2, WS_LAMP)[g * 64 + col], lp1 = WSP(f32x2, WS_LAMP)[g * 64 + 32 + col];
        const f32x2* E = WSP(f32x2, WS_E);
        for (int mch = 0; mch < c; ++mch) {
            const f32x2 e0 = E[((size_t)(s - c + mch) * 64 + g) * 64 + col], e1 = E[((size_t)(s - c + mch) * 64 + g) * 64 + 32 + col];
            const float a = lp0[0] * h0r - lp0[1] * h0i + e0[0], b = lp0[0] * h0i + lp0[1] * h0r + e0[1]; h0r = a; h0i = b;
            const float a1 = lp1[0] * h1r - lp1[1] * h1i + e1[0], b1 = lp1[0] * h1i + lp1[1] * h1r + e1[1]; h1r = a1; h1i = b1;
        }
    }
    bf16x8 cpf[5];
    if (MODE != 0) {
#pragma unroll
        for (int ks = 0; ks < 5; ++ks) cpf[ks] = *(const bf16x8*)(CP + (g * 16 + (lane & 15)) * 160 + 32 * ks + 8 * (lane >> 4));
    }
    for (int step = 0; step < nsteps; ++step) {
        const int arow = rowA + step * 16 + tr;
        const float rs = MODE == 2 ? srow_rstd(WSP(float, WS_SSQS), arow - MP) : row_rstd<16>(SSQ, arow);
        f32x4 u0, u1; bf8_to_f32(*(const u32x4*)(XBp + (size_t)arow * D + g * 16 + 8 * hi), u0, u1);
        u32x4 aw; aw.x = pk2(u0[0] * rs, u0[1] * rs); aw.y = pk2(u0[2] * rs, u0[3] * rs); aw.z = pk2(u1[0] * rs, u1[1] * rs); aw.w = pk2(u1[2] * rs, u1[3] * rs);
        const bf16x8 af = __builtin_bit_cast(bf16x8, aw);
        f32x16 bu[4];
#pragma unroll
        for (int nb = 0; nb < 4; ++nb) { f32x16 z = {}; bu[nb] = __builtin_amdgcn_mfma_f32_32x32x16_bf16(af, bbf[nb], z, 0, 0, 0); }
        if (MODE != 0) { asm volatile("s_waitcnt lgkmcnt(0)" ::: "memory");
            *(FLAS u32x4*)(hl + (16 * hr + tr) * S5_RS + 256 + 16 * hi) = aw; }
        const int crow0 = hi ? rowC1 : rowC0;
#pragma unroll
        for (int r = 0; r < 16; ++r) {
            if (MODE == 2) {
                const int smp = (crow0 - MP) + r;
                const float s0r = FIN(3)[((size_t)smp * 64 + g) * 64 + col], s0i = FIN(4)[((size_t)smp * 64 + g) * 64 + col];
                const float s1r = FIN(3)[((size_t)smp * 64 + g) * 64 + 32 + col], s1i = FIN(4)[((size_t)smp * 64 + g) * 64 + 32 + col];
                h0r = lam0[0] * s0r - lam0[1] * s0i + bu[0][r]; h0i = lam0[0] * s0i + lam0[1] * s0r + bu[2][r];
                h1r = lam1[0] * s1r - lam1[1] * s1i + bu[1][r]; h1i = lam1[0] * s1i + lam1[1] * s1r + bu[3][r];
                F.out[O_S5RE_S + ((size_t)smp * 64 + g) * 64 + col] = h0r; F.out[O_S5IM_S + ((size_t)smp * 64 + g) * 64 + col] = h0i;
                F.out[O_S5RE_S + ((size_t)smp * 64 + g) * 64 + 32 + col] = h1r; F.out[O_S5IM_S + ((size_t)smp * 64 + g) * 64 + 32 + col] = h1i;
            } else {
                const float a = lam0[0] * h0r - lam0[1] * h0i + bu[0][r], b = lam0[0] * h0i + lam0[1] * h0r + bu[2][r]; h0r = a; h0i = b;
                const float a1 = lam1[0] * h1r - lam1[1] * h1i + bu[1][r], b1 = lam1[0] * h1i + lam1[1] * h1r + bu[3][r]; h1r = a1; h1i = b1;
            }
            if (MODE != 0) { u32x2 w; w.x = pk2(h0r, h0i); w.y = pk2(h1r, h1i); *(FLAS u32x2*)(hl + (16 * hi + r) * S5_RS + 8 * col) = w; }
        }
        if (MODE != 0) {
            asm volatile("s_waitcnt lgkmcnt(0)" ::: "memory");
#pragma unroll
            for (int tile = 0; tile < 2; ++tile) {
                f32x4 y = {0.f, 0.f, 0.f, 0.f};
#pragma unroll
                for (int ks = 0; ks < 5; ++ks) {
                    bf16x8 a = *(const FLAS bf16x8*)(hl + (16 * tile + (lane & 15)) * S5_RS + 64 * ks + 16 * (lane >> 4));
                    if (ks == 4 && (lane >> 4) >= 2) a = (bf16x8){0, 0, 0, 0, 0, 0, 0, 0};
                    y = __builtin_amdgcn_mfma_f32_16x16x32_bf16(a, cpf[ks], y, 0, 0, 0);
                }
                bf16_t* YG = WSP(bf16_t, WS_AB);
                const int yrow = (tile ? rowC1 : rowC0) + step * 16 + 4 * (lane >> 4);
#pragma unroll
                for (int j = 0; j < 4; ++j) { const float v = y[j]; const float z = 0.7978845608028654f * (v + 0.044715f * v * v * v);
                    const float ge = v * fast_rcp(1.0f + fast_exp(-2.0f * z));
                    YG[(size_t)(yrow + j) * D + g * 16 + (lane & 15)] = (bf16_t)f2bf(ge); }
            }
        }
    }
    if (MODE == 0) {
        f32x2* E = WSP(f32x2, WS_E); const int s = sp + 64 * hi;
        E[((size_t)s * 64 + g) * 64 + col] = (f32x2){h0r, h0i}; E[((size_t)s * 64 + g) * 64 + 32 + col] = (f32x2){h1r, h1i};
    }
    if (MODE == 1) {
        const int s = sp + 64 * hi;
        if ((s & 15) == 15) { const int b = s >> 4;
            F.out[O_S5RE_P + ((size_t)b * 64 + g) * 64 + col] = h0r; F.out[O_S5IM_P + ((size_t)b * 64 + g) * 64 + col] = h0i;
            F.out[O_S5RE_P + ((size_t)b * 64 + g) * 64 + 32 + col] = h1r; F.out[O_S5IM_P + ((size_t)b * 64 + g) * 64 + 32 + col] = h1i; }
    }
}
template <int MODE> __device__ __forceinline__ void phase_s5(Frame& F) {
    for (int t = F.vcu; t < 512; t += F.G) s5_task<MODE>(F, t & 7, t >> 3);
    if (MODE == 1) { for (int t = F.vcu; t < 32; t += F.G) s5_task<2>(F, t & 7, t >> 3); }
    asm volatile("s_waitcnt lgkmcnt(0)" ::: "memory");
}
__device__ __forceinline__ int crow(int r, int hi) { return (r & 3) + 8 * (r >> 2) + 4 * hi; }
template <int PITCH> __device__ __forceinline__ void attn_stage_tile(Frame& F, const bf16_t* __restrict__ src  ) {
    const int r0 = F.tid >> 5, ch = F.tid & 31;
    const bf16_t* g0 = src + (size_t)r0 * PITCH + 8 * ch;
    FLAS unsigned char* l0 = F.lds + r0 * 512 + ((ch ^ (r0 & 15)) << 4);
    u32x4 v[16];
#pragma unroll
    for (int i = 0; i < 16; ++i) v[i] = *(const u32x4*)(g0 + (size_t)(16 * i) * PITCH);
    __builtin_amdgcn_sched_barrier(0);
#pragma unroll
    for (int i = 0; i < 16; ++i) *(FLAS u32x4*)(l0 + i * 8192) = v[i];
    __builtin_amdgcn_sched_barrier(0);
}
__device__ __forceinline__ bf16x8 attn_frag(const FLAS unsigned char* lds, int row, int ch) { return *(const FLAS bf16x8*)(lds + row * 512 + ((ch ^ (row & 15)) << 4)); }
__device__ __forceinline__ void attn_prompt_unit(Frame& F, int layer, int unit) {
    const int lane = F.lane, ql = lane & 31, hh = lane >> 5;
    const int b = unit >> 5, h = (unit >> 3) & 3, qb = unit & 7;
    const bf16_t* QB = WSP(bf16_t, WS_QB); const bf16_t* KB = WSP(bf16_t, WS_KBM) + (size_t)layer * 2048 * D; const bf16_t* VT = WSP(bf16_t, WS_VTM) + (size_t)layer * 8 * 4 * 256 * 256;
    bf16_t* AB = WSP(bf16_t, WS_AB);
    const int row = b * T + qb * 256 + F.wave * 32 + ql;
    const bf16_t* qp = QB + (size_t)row * D + h * 256 + 8 * hh;
    attn_stage_tile<D>(F, KB + ((size_t)b * 256) * D + h * 256);
    asm volatile("s_waitcnt vmcnt(0) lgkmcnt(0)" ::: "memory"); __builtin_amdgcn_s_barrier(); asm volatile("" ::: "memory");
    f32x16 s[8];
#pragma unroll
    for (int kb = 0; kb < 8; ++kb) s[kb] = (f32x16){};
#pragma unroll
    for (int ks = 0; ks < 16; ++ks) {
        bf16x8 kf[8]; const bf16x8 qf = *(const bf16x8*)(qp + 16 * ks);
#pragma unroll
        for (int kb = 0; kb < 8; ++kb) kf[kb] = attn_frag(F.lds, 32 * kb + ql, 2 * ks + hh);
        __builtin_amdgcn_sched_barrier(0);
#pragma unroll
        for (int kb = 0; kb < 8; ++kb) s[kb] = __builtin_amdgcn_mfma_f32_32x32x16_bf16(kf[kb], qf, s[kb], 0, 0, 0);
        __builtin_amdgcn_sched_barrier(0);
    }
    asm volatile("s_waitcnt lgkmcnt(0)" ::: "memory"); __builtin_amdgcn_s_barrier(); asm volatile("" ::: "memory");
    float mx = -3.0e38f;
#pragma unroll
    for (int kb = 0; kb < 8; ++kb)
#pragma unroll
        for (int r = 0; r < 16; ++r) mx = fmaxf(mx, s[kb][r]);
    mx = fmaxf(mx, __shfl_xor(mx, 32));
    float l = 0.f;
    bf16x8 pf[8][2];
#pragma unroll
    for (int kb = 0; kb < 8; ++kb) {
        float p[16];
#pragma unroll
        for (int r = 0; r < 16; ++r) { p[r] = __builtin_amdgcn_exp2f(s[kb][r] - mx); l += p[r]; }
#pragma unroll
        for (int s2 = 0; s2 < 2; ++s2) { u32x4 w; w.x = pk2(p[8 * s2 + 0], p[8 * s2 + 1]); w.y = pk2(p[8 * s2 + 2], p[8 * s2 + 3]); w.z = pk2(p[8 * s2 + 4], p[8 * s2 + 5]); w.w = pk2(p[8 * s2 + 6], p[8 * s2 + 7]);
            pf[kb][s2] = __builtin_bit_cast(bf16x8, w); }
    }
    l += __shfl_xor(l, 32);
    const float inv = 1.0f / l;
    attn_stage_tile<256>(F, VT + (((size_t)b * 4 + h) * 256) * 256);
    asm volatile("s_waitcnt vmcnt(0) lgkmcnt(0)" ::: "memory"); __builtin_amdgcn_s_barrier(); asm volatile("" ::: "memory");
#pragma unroll 1
    for (int half = 0; half < 2; ++half) {
        f32x16 o[4];
#pragma unroll
        for (int i = 0; i < 4; ++i) o[i] = (f32x16){};
#pragma unroll
        for (int st = 0; st < 16; st += 2) {
            bf16x8 vf[8];
#pragma unroll
            for (int j = 0; j < 8; ++j) vf[j] = attn_frag(F.lds, 32 * (4 * half + (j & 3)) + ql, 2 * (st + (j >> 2)) + hh);
            __builtin_amdgcn_sched_barrier(0);
#pragma unroll
            for (int j = 0; j < 8; ++j) o[j & 3] = __builtin_amdgcn_mfma_f32_32x32x16_bf16(vf[j], pf[(st + (j >> 2)) >> 1][(st + (j >> 2)) & 1], o[j & 3], 0, 0, 0);
            __builtin_amdgcn_sched_barrier(0);
        }
#pragma unroll
        for (int i = 0; i < 4; ++i)
#pragma unroll
            for (int r4 = 0; r4 < 4; ++r4) { u32x2 w; w.x = pk2(o[i][4 * r4] * inv, o[i][4 * r4 + 1] * inv); w.y = pk2(o[i][4 * r4 + 2] * inv, o[i][4 * r4 + 3] * inv);
                *(u32x2*)(AB + (size_t)row * D + h * 256 + 32 * (4 * half + i) + 8 * r4 + 4 * hh) = w; }
    }
    asm volatile("s_waitcnt lgkmcnt(0)" ::: "memory"); __builtin_amdgcn_s_barrier(); asm volatile("" ::: "memory");
}
#define TR_LEVEL(N_, SH_) _Pragma("unroll") for (int i = 0; i < (N_); ++i) { const bool up = (lane & (SH_)) != 0; const float keep = up ? v[2 * i + 1] : v[2 * i], send = up ? v[2 * i] : v[2 * i + 1]; v[i] = keep + __shfl_xor(send, (SH_)); }
__device__ __forceinline__ float transpose_reduce64(float (&v)[64], int lane) {
    TR_LEVEL(32, 1) TR_LEVEL(16, 2) TR_LEVEL(8, 4) TR_LEVEL(4, 8) TR_LEVEL(2, 16) TR_LEVEL(1, 32)
    return v[0];
}
__device__ __forceinline__ void attn_sample_unit(Frame& F, int layer, int unit) {
    const int lane = F.lane, w = F.wave, b = unit >> 1, hp = unit & 1, hl = w >> 2, head = 2 * hp + hl, kq = w & 3;
    FLAS float* sc = (FLAS float*)F.lds;
    FLAS float* op = (FLAS float*)(F.lds + 2048);
    FLAS float* ls = (FLAS float*)(F.lds + 2048 + 8192);
    const bf16_t* QB = WSP(bf16_t, WS_QB); bf16_t* AB = WSP(bf16_t, WS_AB);
    const float* Kc = FIN(6) + (((size_t)layer * MS + b) * NMEM + 64 * kq) * D + head * 256 + 4 * lane;
    const float* Vc = FIN(7) + (((size_t)layer * MS + b) * NMEM + 64 * kq) * D + head * 256 + 4 * lane;
    const u32x2 qw = *(const u32x2*)(QB + (size_t)(MP + b) * D + head * 256 + 4 * lane);
    const float q0 = bflo(qw.x), q1 = bfhi(qw.x), q2 = bflo(qw.y), q3 = bfhi(qw.y);
    float v[64];
#pragma unroll
    for (int bt = 0; bt < 4; ++bt) { f32x4 kv[16];
#pragma unroll
        for (int i = 0; i < 16; ++i) kv[i] = __builtin_nontemporal_load((const f32x4*)(Kc + (size_t)(16 * bt + i) * D));
        __builtin_amdgcn_sched_barrier(0);
#pragma unroll
        for (int i = 0; i < 16; ++i) v[16 * bt + i] = (q0 * kv[i][0] + q1 * kv[i][1]) + (q2 * kv[i][2] + q3 * kv[i][3]);
        __builtin_amdgcn_sched_barrier(0); }
    const float sv = transpose_reduce64(v, lane);
    sc[hl * 256 + 64 * kq + lane] = sv;
    asm volatile("s_waitcnt lgkmcnt(0)" ::: "memory"); __builtin_amdgcn_s_barrier(); asm volatile("" ::: "memory");
    float mx = fmaxf(fmaxf(sc[hl * 256 + lane], sc[hl * 256 + 64 + lane]), fmaxf(sc[hl * 256 + 128 + lane], sc[hl * 256 + 192 + lane]));
#pragma unroll
    for (int o = 1; o < 64; o <<= 1) mx = fmaxf(mx, __shfl_xor(mx, o));
    const float pv = __builtin_amdgcn_exp2f(sv - mx);
    const float lpart = wave_sum(pv);
    f32x4 o = {0.f, 0.f, 0.f, 0.f};
#pragma unroll
    for (int bt = 0; bt < 4; ++bt) { f32x4 vv[16];
#pragma unroll
        for (int i = 0; i < 16; ++i) vv[i] = __builtin_nontemporal_load((const f32x4*)(Vc + (size_t)(16 * bt + i) * D));
        __builtin_amdgcn_sched_barrier(0);
#pragma unroll
        for (int i = 0; i < 16; ++i) { const float p = __builtin_bit_cast(float, __builtin_amdgcn_readlane(__builtin_bit_cast(int, pv), 16 * bt + i)); o = o + vv[i] * p; }
        __builtin_amdgcn_sched_barrier(0); }
    *(FLAS f32x4*)(op + (hl * 4 + kq) * 256 + 4 * lane) = o;
    if (lane == 0) ls[hl * 4 + kq] = lpart;
    asm volatile("s_waitcnt lgkmcnt(0)" ::: "memory"); __builtin_amdgcn_s_barrier(); asm volatile("" ::: "memory");
    if (kq == 0) {
        const float inv = 1.0f / ((ls[hl * 4] + ls[hl * 4 + 1]) + (ls[hl * 4 + 2] + ls[hl * 4 + 3]));
        f32x4 t = *(const FLAS f32x4*)(op + (hl * 4) * 256 + 4 * lane);
#pragma unroll
        for (int j = 1; j < 4; ++j) t = t + *(const FLAS f32x4*)(op + (hl * 4 + j) * 256 + 4 * lane);
        u32x2 wv; wv.x = pk2(t[0] * inv, t[1] * inv); wv.y = pk2(t[2] * inv, t[3] * inv);
        *(u32x2*)(AB + (size_t)(MP + b) * D + head * 256 + 4 * lane) = wv;
    }
    asm volatile("s_waitcnt lgkmcnt(0)" ::: "memory"); __builtin_amdgcn_s_barrier(); asm volatile("" ::: "memory");
}
__device__ __forceinline__ void phase_attn(Frame& F, int layer) {
#if defined(ATREP)
    for (int r_ = 0; r_ < (((ATREP) & 1) ? 2 : 0); ++r_) { asm volatile("" ::: "memory"); for (int u = F.vcu; u < 256; u += F.G) attn_prompt_unit(F, layer, u); }
    for (int r_ = 0; r_ < (((ATREP) & 2) ? 2 : 0); ++r_) { asm volatile("" ::: "memory"); for (int u = F.vcu; u < 256; u += F.G) attn_sample_unit(F, layer, u); }
#endif
    for (int u = F.vcu; u < 256; u += F.G) attn_prompt_unit(F, layer, u);
    for (int u = F.vcu; u < 256; u += F.G) attn_sample_unit(F, layer, u);
}

constexpr int VRS = 320;
__device__ __forceinline__ void stage_v_tile(Frame& F, FLAS unsigned char* vt, int row0, int h) {
    const bf16_t* VN = WSP(bf16_t, WS_VT);
#pragma unroll
    for (int i = 0; i < 2; ++i) { const int r = 8 * F.wave + 4 * i + (F.lane >> 4), ch = F.lane & 15;
        const u32x4 v = *(const u32x4*)(VN + (size_t)(row0 + r) * D + h * 128 + 8 * ch); *(FLAS u32x4*)(vt + r * VRS + 16 * ch) = v; }
}
typedef short v4i16_t __attribute__((ext_vector_type(4)));
__device__ __forceinline__ bf16x8 vt_frag(const FLAS unsigned char* vt, int vb, int ts, int lane) {
    const int hh = lane >> 5, q = (lane & 15) >> 2, p = lane & 3, cb = 32 * vb + 16 * ((lane >> 4) & 1);
    const FLAS unsigned char* a0 = vt + (16 * ts + 4 * hh + q) * VRS + 2 * (cb + 4 * p);
    const v4i16_t lo = __builtin_amdgcn_ds_read_tr16_b64_v4i16((FLAS v4i16_t*)a0);
    const v4i16_t hi = __builtin_amdgcn_ds_read_tr16_b64_v4i16((FLAS v4i16_t*)(a0 + 8 * VRS));
    return (bf16x8){lo[0], lo[1], lo[2], lo[3], hi[0], hi[1], hi[2], hi[3]};
}
__device__ __forceinline__ void hga_unit(Frame& F, int unit) {
    const int lane = F.lane, w = F.wave, kb = w & 3, vh = w >> 2, kc = lane & 31, hh = lane >> 5;
    const int bh = unit >> 5, n = unit & 31, b = bh >> 3, h = bh & 7;
    FLAS unsigned char* vt = F.lds;
    const float* LOGF = WSP(float, WS_LOGF) + ((size_t)b * T + n * 64) * D + h * 128 + 32 * kb + kc;
    float kd[64]; float suf = 0.f;
#pragma unroll
    for (int t = 0; t < 64; ++t) kd[t] = LOGF[(size_t)t * D];
    __builtin_amdgcn_sched_barrier(0);
    stage_v_tile(F, vt, b * T + n * 64, h);
    __builtin_amdgcn_sched_barrier(0);
#pragma unroll
    for (int t = 63; t >= 0; --t) { const float lf = kd[t]; kd[t] = (1.0f - fast_exp(lf)) * fast_exp(suf); suf += lf; }
    bf16x8 kf[4];
#pragma unroll
    for (int ts = 0; ts < 4; ++ts) { float e[8];
#pragma unroll
        for (int j = 0; j < 8; ++j) { const int tlo = 16 * ts + 8 * (j >> 2) + (j & 3); e[j] = hh ? kd[tlo + 4] : kd[tlo]; }
        u32x4 wv; wv.x = pk2(e[0], e[1]); wv.y = pk2(e[2], e[3]); wv.z = pk2(e[4], e[5]); wv.w = pk2(e[6], e[7]); kf[ts] = __builtin_bit_cast(bf16x8, wv); }
    asm volatile("s_waitcnt vmcnt(0) lgkmcnt(0)" ::: "memory"); __builtin_amdgcn_s_barrier(); asm volatile("" ::: "memory");
    bf16_t* SL = WSP(bf16_t, WS_SLOC) + (size_t)unit * 16384;
#pragma unroll
    for (int vi = 0; vi < 2; ++vi) { const int vb = 2 * vh + vi; f32x16 acc = {};
#pragma unroll
        for (int ts = 0; ts < 4; ++ts) { const bf16x8 vf = vt_frag(vt, vb, ts, lane); acc = __builtin_amdgcn_mfma_f32_32x32x16_bf16(vf, kf[ts], acc, 0, 0, 0); }
#pragma unroll
        for (int r = 0; r < 16; ++r) SL[(size_t)(32 * vb + crow(r, hh)) * 128 + 32 * kb + kc] = (bf16_t)f2bf(acc[r]); }
    if (vh == 0 && hh == 0) WSP(float, WS_BT)[(size_t)unit * 128 + 32 * kb + kc] = suf;
    asm volatile("s_waitcnt lgkmcnt(0)" ::: "memory"); __builtin_amdgcn_s_barrier(); asm volatile("" ::: "memory");
}
__device__ __forceinline__ void phase_hgb(Frame& F) {
    const bf16_t* SL = WSP(bf16_t, WS_SLOC); const float* BT = WSP(float, WS_BT); bf16_t* SST = WSP(bf16_t, WS_SST);
    for (int chain = F.vcu * NTHR + F.tid; chain < 64 * 128 * 32; chain += F.G * NTHR) {
        const int bh = chain >> 12, v = (chain >> 5) & 127, k4 = chain & 31;
        f32x4 S = {0.f, 0.f, 0.f, 0.f};
        for (int n = 0; n < 32; ++n) {
            const size_t u = (size_t)bh * 32 + n;
            u32x2 wv; wv.x = pk2(S[0], S[1]); wv.y = pk2(S[2], S[3]); *(u32x2*)(SST + u * 16384 + v * 128 + 4 * k4) = wv;
            const u32x2 lw_ = *(const u32x2*)(SL + u * 16384 + v * 128 + 4 * k4); const f32x4 loc = {bflo(lw_.x), bfhi(lw_.x), bflo(lw_.y), bfhi(lw_.y)}, bt = *(const f32x4*)(BT + u * 128 + 4 * k4);
#pragma unroll
            for (int i = 0; i < 4; ++i) S[i] = fast_exp(bt[i]) * S[i] + loc[i];
        }
#pragma unroll
        for (int i = 0; i < 4; ++i) F.out[O_HG_P + ((size_t)bh * 128 + 4 * k4 + i) * 128 + v] = S[i];
    }
}
constexpr int HC_RS = 272;
struct HgcPre { f32x4 lf[4]; u32x4 q[2]; u32x4 v[2]; bf16x8 sa[8]; u32x2 g[4]; };
__device__ __forceinline__ void hgc_prefetch(Frame& F, int unit, HgcPre& P) {
    const int lane = F.lane, w = F.wave;
    const int bh = unit >> 5, n = unit & 31, b = bh >> 3, h = bh & 7, row0 = b * T + n * 64;
    const size_t off = (size_t)(row0 + lane) * D + h * 128 + 16 * w;
#pragma unroll
    for (int i = 0; i < 4; ++i) P.lf[i] = *(const f32x4*)(WSP(float, WS_LOGF) + off + 4 * i);
    P.q[0] = *(const u32x4*)(WSP(bf16_t, WS_QB) + off); P.q[1] = *(const u32x4*)(WSP(bf16_t, WS_QB) + off + 8);
#pragma unroll
    for (int i = 0; i < 2; ++i) { const int r = 8 * w + 4 * i + (lane >> 4), ch = lane & 15; P.v[i] = *(const u32x4*)(WSP(bf16_t, WS_VT) + (size_t)(row0 + r) * D + h * 128 + 8 * ch); }
    const int tb = w & 1, vb = w >> 1, tl = lane & 31, hh = lane >> 5;
    const bf16_t* SST = WSP(bf16_t, WS_SST) + (size_t)unit * 16384 + (size_t)(32 * vb + tl) * 128 + 8 * hh;
#pragma unroll
    for (int ks = 0; ks < 8; ++ks) P.sa[ks] = *(const bf16x8*)(SST + 16 * ks);
    const size_t orow = (size_t)(row0 + 32 * tb + tl) * D + h * 128 + 32 * vb;
#pragma unroll
    for (int r4 = 0; r4 < 4; ++r4) P.g[r4] = *(const u32x2*)(WSP(bf16_t, WS_GH) + orow + 8 * r4 + 4 * hh);
}
__device__ __forceinline__ void hgc_unit(Frame& F, int unit, const HgcPre& P) {
    const int lane = F.lane, w = F.wave;
    const int bh = unit >> 5, n = unit & 31, b = bh >> 3, h = bh & 7;
    FLAS unsigned char* QM = F.lds, *KM = F.lds + 64 * HC_RS, *QHT = F.lds + 128 * HC_RS;
    FLAS float* part = (FLAS float*)(F.lds + 192 * HC_RS);
    FLAS unsigned char* vt = F.lds + 192 * HC_RS + 1024;
    const int row0 = b * T + n * 64;
#pragma unroll
    for (int i = 0; i < 2; ++i) { const int r = 8 * w + 4 * i + (lane >> 4), ch = lane & 15; *(FLAS u32x4*)(vt + r * VRS + 16 * ch) = P.v[i]; }
    {
        float bc[16], kk[16];
#pragma unroll
        for (int i = 0; i < 4; ++i) { const f32x4 v = P.lf[i]; bc[4 * i] = v[0]; bc[4 * i + 1] = v[1]; bc[4 * i + 2] = v[2]; bc[4 * i + 3] = v[3]; }
#pragma unroll
        for (int i = 0; i < 16; ++i) kk[i] = 1.0f - fast_exp(bc[i]);
#pragma unroll
        for (int d = 1; d < 64; d <<= 1) {
#pragma unroll
            for (int i = 0; i < 16; ++i) { const float o = __shfl_up(bc[i], d); if (lane >= d) bc[i] += o; }
        }
        const u32x4 qw0 = P.q[0], qw1 = P.q[1];
        float q[16];
        q[0] = bflo(qw0.x); q[1] = bfhi(qw0.x); q[2] = bflo(qw0.y); q[3] = bfhi(qw0.y); q[4] = bflo(qw0.z); q[5] = bfhi(qw0.z); q[6] = bflo(qw0.w); q[7] = bfhi(qw0.w);
        q[8] = bflo(qw1.x); q[9] = bfhi(qw1.x); q[10] = bflo(qw1.y); q[11] = bfhi(qw1.y); q[12] = bflo(qw1.z); q[13] = bfhi(qw1.z); q[14] = bflo(qw1.w); q[15] = bfhi(qw1.w);
        float qm[16], km[16], qh[16];
#pragma unroll
        for (int i = 0; i < 16; ++i) { const float bm = __shfl(bc[i], 31); qm[i] = q[i] * fast_exp(bc[i] - bm); km[i] = kk[i] * fast_exp(bm - bc[i]); qh[i] = q[i] * fast_exp(bc[i]); }
#define HC_PACK8(a, o_) ((u32x4){pk2(a[o_], a[o_ + 1]), pk2(a[o_ + 2], a[o_ + 3]), pk2(a[o_ + 4], a[o_ + 5]), pk2(a[o_ + 6], a[o_ + 7])})
        *(FLAS u32x4*)(QM + lane * HC_RS + 32 * w) = HC_PACK8(qm, 0); *(FLAS u32x4*)(QM + lane * HC_RS + 32 * w + 16) = HC_PACK8(qm, 8);
        *(FLAS u32x4*)(KM + lane * HC_RS + 32 * w) = HC_PACK8(km, 0); *(FLAS u32x4*)(KM + lane * HC_RS + 32 * w + 16) = HC_PACK8(km, 8);
        *(FLAS u32x4*)(QHT + lane * HC_RS + 32 * w) = HC_PACK8(qh, 0); *(FLAS u32x4*)(QHT + lane * HC_RS + 32 * w + 16) = HC_PACK8(qh, 8);
    }
    asm volatile("s_waitcnt lgkmcnt(0)" ::: "memory"); __builtin_amdgcn_s_barrier(); asm volatile("" ::: "memory");
    const int tb = w & 1, vb = w >> 1, tl = lane & 31, hh = lane >> 5, tglob = 32 * tb + tl;
    f32x16 acc = {};
#pragma unroll
    for (int ks = 0; ks < 8; ++ks) { const bf16x8 bq = *(const FLAS bf16x8*)(QHT + tglob * HC_RS + 32 * ks + 16 * hh);
        acc = __builtin_amdgcn_mfma_f32_32x32x16_bf16(P.sa[ks], bq, acc, 0, 0, 0); }
#pragma unroll
    for (int sb = 0; sb < 2; ++sb) {
        if (sb <= tb) {
            f32x16 x = {};
#pragma unroll
            for (int ks = 0; ks < 8; ++ks) { const bf16x8 a = *(const FLAS bf16x8*)(KM + (32 * sb + tl) * HC_RS + 32 * ks + 16 * hh); const bf16x8 bq = *(const FLAS bf16x8*)(QM + tglob * HC_RS + 32 * ks + 16 * hh);
                x = __builtin_amdgcn_mfma_f32_32x32x16_bf16(a, bq, x, 0, 0, 0); }
            if (sb == tb) {
#pragma unroll
                for (int r = 0; r < 16; ++r) if (crow(r, hh) > tl) x[r] = 0.f;
            }
#pragma unroll
            for (int s2 = 0; s2 < 2; ++s2) { u32x4 wv; wv.x = pk2(x[8 * s2], x[8 * s2 + 1]); wv.y = pk2(x[8 * s2 + 2], x[8 * s2 + 3]); wv.z = pk2(x[8 * s2 + 4], x[8 * s2 + 5]); wv.w = pk2(x[8 * s2 + 6], x[8 * s2 + 7]);
                const bf16x8 a = vt_frag(vt, vb, 2 * sb + s2, lane);
                acc = __builtin_amdgcn_mfma_f32_32x32x16_bf16(a, __builtin_bit_cast(bf16x8, wv), acc, 0, 0, 0); }
        }
    }
    float sq = 0.f;
#pragma unroll
    for (int r = 0; r < 16; ++r) sq += acc[r] * acc[r];
    sq += __shfl_xor(sq, 32);
    if (hh == 0) part[vb * 64 + tglob] = sq;
    asm volatile("s_waitcnt lgkmcnt(0)" ::: "memory"); __builtin_amdgcn_s_barrier(); asm volatile("" ::: "memory");
    const float tot = (part[tglob] + part[64 + tglob]) + (part[128 + tglob] + part[192 + tglob]);
    const float rs = 1.0f / sqrtf(tot * (1.0f / 128.0f) + EPS);
    const size_t orow = (size_t)(row0 + tglob) * D + h * 128 + 32 * vb;
    const float* ng = FIN(31);
#pragma unroll
    for (int r4 = 0; r4 < 4; ++r4) { const int v0 = 8 * r4 + 4 * hh;
        const u32x2 gw = P.g[r4]; const f32x4 gn = *(const f32x4*)(ng + 32 * vb + v0);
        u32x2 wv; wv.x = pk2(acc[4 * r4] * rs * gn[0] * bflo(gw.x), acc[4 * r4 + 1] * rs * gn[1] * bfhi(gw.x)); wv.y = pk2(acc[4 * r4 + 2] * rs * gn[2] * bflo(gw.y), acc[4 * r4 + 3] * rs * gn[3] * bfhi(gw.y));
        *(u32x2*)(WSP(bf16_t, WS_AB) + orow + v0) = wv; }
    asm volatile("s_waitcnt lgkmcnt(0)" ::: "memory"); __builtin_amdgcn_s_barrier(); asm volatile("" ::: "memory");
}
__device__ __forceinline__ void phase_hgc(Frame& F) {
    HgcPre P; int u = F.vcu;
    if (u < 2048) hgc_prefetch(F, u, P);
    for (; u < 2048; u += F.G) {
        const HgcPre C = P; const int un = u + F.G;
        if (un < 2048) hgc_prefetch(F, un, P);
        __builtin_amdgcn_sched_barrier(0);
        hgc_unit(F, u, C);
    }
}
__device__ __forceinline__ void hg_sample_wave(Frame& F, int unit) {
    const int lane = F.lane, b = unit >> 3, h = unit & 7, v4 = lane & 31, kp = lane >> 5;
    const size_t rowo = (size_t)(MP + b) * D + h * 128;
    const float* S0 = FIN(5) + ((size_t)unit * 128) * 128 + 4 * v4; float* So = F.out + O_HG_S + ((size_t)unit * 128) * 128 + 4 * v4;
    const f32x2 lfp = *(const f32x2*)(WSP(float, WS_LOGF) + rowo + 2 * lane);
    const unsigned qp = *(const unsigned*)(WSP(bf16_t, WS_QB) + rowo + 2 * lane);
    const u32x2 vw_ = *(const u32x2*)(WSP(bf16_t, WS_VT) + rowo + 4 * v4); const f32x4 vv = {bflo(vw_.x), bfhi(vw_.x), bflo(vw_.y), bfhi(vw_.y)};
    const u32x2 gw = *(const u32x2*)(WSP(bf16_t, WS_GH) + rowo + 4 * v4); const f32x4 gn = *(const f32x4*)(FIN(31) + 4 * v4);
    const float fx = fast_exp(lfp[0]), fy = fast_exp(lfp[1]), qx = bflo(qp), qy = bfhi(qp);
    f32x4 o = {0.f, 0.f, 0.f, 0.f};
#pragma unroll
    for (int it = 0; it < 4; ++it) {
        f32x4 s0[16];
#pragma unroll
        for (int i = 0; i < 16; ++i) s0[i] = __builtin_nontemporal_load((const f32x4*)(S0 + (size_t)(32 * it + 2 * i + kp) * 128));
        __builtin_amdgcn_sched_barrier(0);
#pragma unroll
        for (int i = 0; i < 16; ++i) { const int src = 16 * it + i;
            const float f0 = __builtin_bit_cast(float, __builtin_amdgcn_readlane(__builtin_bit_cast(int, fx), src)), f1 = __builtin_bit_cast(float, __builtin_amdgcn_readlane(__builtin_bit_cast(int, fy), src));
            const float q0 = __builtin_bit_cast(float, __builtin_amdgcn_readlane(__builtin_bit_cast(int, qx), src)), q1 = __builtin_bit_cast(float, __builtin_amdgcn_readlane(__builtin_bit_cast(int, qy), src));
            const float f = kp ? f1 : f0, q = kp ? q1 : q0, kk = 1.0f - f;
            const f32x4 sn = s0[i] * f + vv * kk;
            __builtin_nontemporal_store(sn, (f32x4*)(So + (size_t)(32 * it + 2 * i + kp) * 128)); o = o + sn * q; }
        __builtin_amdgcn_sched_barrier(0);
    }
#pragma unroll
    for (int j = 0; j < 4; ++j) o[j] += __shfl_xor(o[j], 32);
    float sq = (o[0] * o[0] + o[1] * o[1]) + (o[2] * o[2] + o[3] * o[3]);
    sq += __shfl_xor(sq, 1); sq += __shfl_xor(sq, 2); sq += __shfl_xor(sq, 4); sq += __shfl_xor(sq, 8); sq += __shfl_xor(sq, 16);
    const float rs = 1.0f / sqrtf(sq * (1.0f / 128.0f) + EPS);
    if (kp == 0) { u32x2 wv; wv.x = pk2(o[0] * rs * gn[0] * bflo(gw.x), o[1] * rs * gn[1] * bfhi(gw.x)); wv.y = pk2(o[2] * rs * gn[2] * bflo(gw.y), o[3] * rs * gn[3] * bfhi(gw.y));
        *(u32x2*)(WSP(bf16_t, WS_AB) + rowo + 4 * v4) = wv; }
}
__device__ __forceinline__ void phase_final(Frame& F) {
    const int gw = F.vcu * NWAVES + F.wave, NGW = F.G * NWAVES, lane = F.lane;
    const bf16_t* XBp = WSP(bf16_t, WS_XB); const float* SSQ = WSP(float, WS_SSQ); const float* g = FIN(33);
    for (int row = gw; row < R; row += NGW) {
        const float rs = row < MP ? row_rstd<16>(SSQ, row) : srow_rstd(WSP(float, WS_SSQS), row - MP);
#pragma unroll
        for (int j = 0; j < 2; ++j) { f32x4 v0, v1; bf8_to_f32(((const u32x4*)(XBp + (size_t)row * D))[lane + 64 * j], v0, v1);
            const f32x4 g0 = ((const f32x4*)g)[2 * (lane + 64 * j)], g1 = ((const f32x4*)g)[2 * (lane + 64 * j) + 1];
            ((f32x4*)(F.out + (size_t)row * D))[2 * (lane + 64 * j)] = v0 * rs * g0; ((f32x4*)(F.out + (size_t)row * D))[2 * (lane + 64 * j) + 1] = v1 * rs * g1; }
    }
}
constexpr int NPHASE = 24;
#ifndef PHM
#define PHM 0xFFFFFFu
#endif
#define PHON(k) (((PHM) >> (k)) & 1u)
__global__ void __launch_bounds__(NTHR, 2) mega(Args args) {
    extern __shared__ __attribute__((aligned(16))) unsigned char lds_raw[];
    Frame F;
    F.lds = (FLAS unsigned char*)lds_raw;
    F.tid = threadIdx.x; F.lane = F.tid & 63; F.wave = __builtin_amdgcn_readfirstlane(F.tid >> 6);
    const int wave_s = F.wave;
    F.G = gridDim.x; { const int bx = blockIdx.x; F.vcu = (F.G % 8 == 0) ? (bx % 8) * (F.G / 8) + bx / 8 : bx; }
    { KAS const char* ka0 = (KAS const char*)__builtin_amdgcn_kernarg_segment_ptr(); F.ka = ka0; F.out = *(float* KAS const*)(ka0 + 272); F.ws = *(unsigned char* KAS const*)(ka0 + 280); }
    volatile FLAS unsigned* MISC = (volatile FLAS unsigned*)(F.lds + MISC_OFF);
    for (int u = F.tid; u < (LDS_BYTES - LDSCTL_OFF) / 4; u += NTHR) ((FLAS unsigned*)(F.lds + LDSCTL_OFF))[u] = 0u;
    __syncthreads();
    XcdBarrier bar = xcd_barrier_post((unsigned*)(F.ws + WS_CTL) + 4096 + args.ph_lo * XCD_BAR_WORDS, MISC + 8, F.tid == 0);
    const int bx0 = (int)blockIdx.x, G0 = F.G, vcu0 = F.vcu;
#if defined(REPM)
    int rl_ = -1;
#endif
#if defined(PHT)
    unsigned long long pht_acc_ = 0ull;
#endif
#pragma nounroll
    for (int ph = args.ph_lo; ph < args.ph_hi; ++ph) {
        int bx = bx0, G_ = G0, vcu_ = vcu0, wv_ = wave_s;
        asm volatile("" : "+s"(bx), "+s"(G_), "+s"(vcu_), "+s"(wv_));
        F.G = G_; F.vcu = vcu_;
        { int l_ = (int)__builtin_amdgcn_mbcnt_hi(~0u, __builtin_amdgcn_mbcnt_lo(~0u, 0u)); asm volatile("" : "+v"(l_)); F.lane = l_; F.wave = wv_; F.tid = wv_ * 64 + l_;
          KAS const char* ka_ = (KAS const char*)__builtin_amdgcn_kernarg_segment_ptr(); asm volatile("" : "+s"(ka_)); F.ka = ka_;
          F.out = *(float* KAS const*)(ka_ + 272); F.ws = *(unsigned char* KAS const*)(ka_ + 280); }
        bf16_t* XB = WSP(bf16_t, WS_XB); float* SSQ = WSP(float, WS_SSQ); float* SSQS = WSP(float, WS_SSQS); bf16_t* HB = WSP(bf16_t, WS_HB); bf16_t* AB = WSP(bf16_t, WS_AB); bf16_t* QB = WSP(bf16_t, WS_QB);
        const int layer = ph >= 11 ? 1 : 0;
#if defined(PHT)
        const unsigned long long pt0_ = __builtin_amdgcn_s_memrealtime();
#endif
#define SKINNY(PAIRED_, KS_, NT_, EPI_, A_, BT_, NU_, NCU_) do { int ln_ = F.lane; asm volatile("" : "+v"(ln_)); const auto e_ = EPI_; if (G_ - 1 - bx < (NCU_)) for (int u_ = G_ - 1 - bx; u_ < (NU_); u_ += (NCU_)) skinny_unit<PAIRED_, KS_, NT_>(A_, BT_, u_, F.wave, ln_, F.lds, e_); } while (0)
        if (ph == 0) { if (PHON(0)) phase_prep(F); }
        else if (PHON(1) && (ph == 1 || ph == 9 || ph == 11 || ph == 21)) {
            const bool second = (ph == 9 || ph == 21);
            const bf16_t* Bt = WSP(bf16_t, (second ? WS_W2IN : WS_W1IN) + layer * W1IN_SZ);
            pg8::Gemm g{XB, Bt, MP, 2 * FF, D}; pg8::StaticOrder S; S.init(MP, 2 * FF, F.G, bx);
            EpiSwiglu<16> E{SSQ, HB};
            pg8::gemm_phase<EpiSwiglu<16>, pg8::StaticOrder, true, true>(F.lds, g, S, E, F.tid);
            if (PHON(20) && ph == 1) {
                pg8::Gemm g2{WSP(bf16_t, WS_MEMN), WSP(bf16_t, WS_WKV), 2048, 4096, D}; pg8::StaticOrder S2; S2.init(2048, 4096, F.G, F.G - 1 - bx);
                EpiMemKV E2{F.out, WSP(bf16_t, WS_KBM), WSP(bf16_t, WS_VTM)};
                pg8::gemm_phase<EpiMemKV, pg8::StaticOrder, true, true>(F.lds, g2, S2, E2, F.tid);
                SKINNY(true, 8, 2, (SEpiSwiglu{SSQS, HB}), XB, Bt, 4 * FF / 32, 256);
            } else SKINNY(true, 8, 2, (SEpiSwiglu{SSQS, HB}), XB, Bt, 4 * FF / 32, 128);
        } else if (PHON(2) && (ph == 2 || ph == 10 || ph == 12 || ph == 22 || ph == 8 || ph == 20 || ph == 17)) {
            const bool ffn = (ph == 2 || ph == 10 || ph == 12 || ph == 22);
            const bf16_t* A; const bf16_t* Bt; int K; float sc;
            if (ffn) { const bool second = (ph == 10 || ph == 22); A = HB; Bt = WSP(bf16_t, (second ? WS_W2OUT : WS_W1OUT) + layer * W1OUT_SZ); K = FF; sc = 0.5f; }
            else if (ph == 17) { A = AB; Bt = WSP(bf16_t, WS_WHGOUT); K = D; sc = 1.0f; }
            else { A = AB; Bt = WSP(bf16_t, WS_WO + layer * WQ_SZ); K = D; sc = 1.0f; }
#if defined(REPM)
            if (rl_ >= 0) sc = 0.f;
#endif
            pg8::Gemm g{A, Bt, MP, D, K}; pg8::StaticOrder S; S.init(MP, D, F.G, bx);
            EpiResid E{XB, SSQ, sc};
            pg8::gemm_phase<EpiResid, pg8::StaticOrder, true, true>(F.lds, g, S, E, F.tid);
            if (K == D) SKINNY(false, 8, 1, (SEpiResid{XB, SSQS, sc}), A, Bt, 4 * D / 16, 256); else SKINNY(false, 22, 1, (SEpiResid{XB, SSQS, sc}), A, Bt, 4 * D / 16, 256);
        } else if (PHON(3) && ph == 3) phase_s5<0>(F);
        else if (PHON(4) && ph == 4) phase_s5<1>(F);
        else if (PHON(5) && ph == 5) {
            pg8::Gemm g{AB, WSP(bf16_t, WS_WGLU), MP, 2 * D, D}; pg8::StaticOrder S; S.init(MP, 2 * D, F.G, bx);
            EpiGlu E{XB, SSQ};
            pg8::gemm_phase<EpiGlu, pg8::StaticOrder, true, true>(F.lds, g, S, E, F.tid);
            SKINNY(true, 8, 1, (SEpiGlu{XB, SSQS}), AB, WSP(bf16_t, WS_WGLU), 4 * D / 16, 256);
        } else if (PHON(6) && (ph == 6 || ph == 18)) {
            const bf16_t* Bt = WSP(bf16_t, WS_WQ + layer * WQ_SZ);
            pg8::Gemm g{XB, Bt, MP, D, D}; pg8::StaticOrder S; S.init(MP, D, F.G, bx);
            if (ph == 6) { EpiQ<32> E{SSQ, QB}; pg8::gemm_phase<EpiQ<32>, pg8::StaticOrder, true, true>(F.lds, g, S, E, F.tid); }
            else { EpiQ<16> E{SSQ, QB}; pg8::gemm_phase<EpiQ<16>, pg8::StaticOrder, true, true>(F.lds, g, S, E, F.tid); }
            SKINNY(false, 8, 1, (SEpiQ{SSQS, QB}), XB, Bt, 4 * D / 16, 256);
        } else if (PHON(7) && (ph == 7 || ph == 19)) phase_attn(F, layer);
        else if (PHON(13) && ph == 13) {
            pg8::Gemm g{XB, WSP(bf16_t, WS_WHGIN), MP, 4 * D, D}; pg8::StaticOrder S; S.init(MP, 4 * D, F.G, bx);
            EpiHgIn<16> E{SSQ, WSP(float, WS_LB), QB, WSP(float, WS_LOGF), WSP(bf16_t, WS_VT), WSP(bf16_t, WS_GH)};
            pg8::gemm_phase<EpiHgIn<16>, pg8::StaticOrder, true, true>(F.lds, g, S, E, F.tid);
            SKINNY(false, 8, 2, (SEpiHgIn{SSQS, WSP(float, WS_LB), QB, WSP(float, WS_LOGF), WSP(bf16_t, WS_VT), WSP(bf16_t, WS_GH)}), XB, WSP(bf16_t, WS_WHGIN), 4 * 4 * D / 32, 256);
        } else if (PHON(14) && ph == 14) { for (int u = F.vcu; u < 2048; u += F.G) hga_unit(F, u); }
        else if (PHON(15) && ph == 15) phase_hgb(F);
        else if (PHON(16) && ph == 16) {
#if defined(HGREP)
            for (int r_ = 0; r_ < (((HGREP) & 1) ? 2 : 0); ++r_) { asm volatile("" ::: "memory"); phase_hgc(F); }
            for (int r_ = 0; r_ < (((HGREP) & 2) ? 2 : 0); ++r_) { asm volatile("" ::: "memory"); for (int u = F.vcu * NWAVES + F.wave; u < 1024; u += F.G * NWAVES) hg_sample_wave(F, u); }
#endif
            phase_hgc(F); for (int u = F.vcu * NWAVES + F.wave; u < 1024; u += F.G * NWAVES) hg_sample_wave(F, u); }
        else if (PHON(23) && ph == 23) phase_final(F);
#if defined(REPM)
        if (rl_ < 0) rl_ = (int)(((unsigned)(REPM) >> ph) & 1u) * (REPN);
        if (rl_ > 0) { --rl_; --ph; continue; }
        rl_ = -1;
#endif
        if (ph + 1 < args.ph_hi) xcd_barrier(bar, F.tid == 0);
#if defined(PHT)
        if (((unsigned)(PHT) >> ph) & 1u) pht_acc_ += __builtin_amdgcn_s_memrealtime() - pt0_;
#endif
    }
#if defined(PHT)
    if (blockIdx.x == 0) { const unsigned long long te_ = __builtin_amdgcn_s_memrealtime(); while (__builtin_amdgcn_s_memrealtime() - te_ < 4ull * pht_acc_) __builtin_amdgcn_s_sleep(8); }
#endif
}

static int g_grid = 0;
static inline bool launch_setup() {
    if (g_grid == 0) {
        int dev = 0, cus = 0, per_cu = 0;
        if (hipGetDevice(&dev) != hipSuccess || hipDeviceGetAttribute(&cus, hipDeviceAttributeMultiprocessorCount, dev) != hipSuccess) { fprintf(stderr, "kernel_launch: device query failed\n"); g_grid = -1; return false; }
        if (hipFuncSetAttribute((const void*)mega, hipFuncAttributeMaxDynamicSharedMemorySize, LDS_BYTES) != hipSuccess) { fprintf(stderr, "kernel_launch: hipFuncSetAttribute failed\n"); g_grid = -1; return false; }
        if (hipOccupancyMaxActiveBlocksPerMultiprocessor(&per_cu, (const void*)mega, NTHR, LDS_BYTES) != hipSuccess || per_cu < 1) { fprintf(stderr, "kernel_launch: occupancy query says %d blocks/CU\n", per_cu); }
        (void)hipGetLastError();
        g_grid = cus;
        fprintf(stderr, "kernel_launch: grid %d, occupancy query %d per CU\n", g_grid, per_cu);
    }
    return g_grid > 0;
}
static inline void launch_phases(void* const* d_in, float* out, void* d_ws, int lo, int hi, hipStream_t st) {
    Args a{};
    for (int i = 0; i < 34; ++i) a.in[i] = (const float*)d_in[i];
    a.out = out; a.ws = (unsigned char*)d_ws; a.ph_lo = lo; a.ph_hi = hi;
    hipLaunchKernelGGL(mega, dim3(g_grid), dim3(NTHR), LDS_BYTES, st, a);
}
}
#if defined(DBG_BUILD)
#define WS_NEED_MIB 1020
#else
#define WS_NEED_MIB 616
#endif
extern "C" void kernel_launch(void* const* d_in, const int* in_sizes, int n_in, void* d_out, int out_size, void* d_ws, size_t ws_size, hipStream_t stream) {
    if (n_in != 34 || out_size != 44236800 || ws_size < ((size_t)WS_NEED_MIB << 20)) { fprintf(stderr, "kernel_launch: unexpected sizes n_in=%d out=%d ws=%zu\n", n_in, out_size, ws_size); return; }
    if (!fk::launch_setup()) return;
    hipMemsetAsync((char*)d_ws + fk::WS_CTL, 0, fk::CTL_ZERO_BYTES, stream);
#if defined(DBG_BUILD)
    dbg::forward(d_in, (float*)d_out, (unsigned char*)d_ws, stream);
#else
    fk::launch_phases(d_in, (float*)d_out, d_ws, 0, fk::NPHASE, stream);
#endif
}
```

```cpp
#include <hip/hip_runtime.h>
#include <cstdio>
#include <cstdint>
#include <cmath>
namespace gold {
__device__ __forceinline__ double d_exp(double x) {
    const double LN2 = 0.6931471805599453094172321, ILN2 = 1.4426950408889634073599247;
    double n = __builtin_rint(x * ILN2);
    double r = x - n * LN2;
    double s = 1.0, term = 1.0;
#pragma unroll
    for (int i = 1; i <= 16; ++i) { term *= r / (double)i; s += term; }
    long long e = (long long)n + 1023;
    double sc = __builtin_bit_cast(double, (unsigned long long)e << 52);
    return s * sc;
}
__device__ __forceinline__ void d_sincos(double th, double& sn, double& cs) {
    const double HPI = 1.5707963267948966192313217, IHPI = 0.63661977236758134307553505;
    double q = __builtin_rint(th * IHPI);
    double r = th - q * HPI;
    double r2 = r * r;
    double s = 0.0, c = 0.0;
    double ts = r, tc = 1.0; s = ts; c = tc;
#pragma unroll
    for (int i = 1; i <= 9; ++i) { tc *= -r2 / (double)((2 * i - 1) * (2 * i)); c += tc; ts *= -r2 / (double)((2 * i) * (2 * i + 1)); s += ts; }
    int qi = ((int)q) & 3;
    if (qi == 0) { sn = s; cs = c; } else if (qi == 1) { sn = c; cs = -s; } else if (qi == 2) { sn = -s; cs = -c; } else { sn = -c; cs = s; }
}
}
namespace pg8 {
#define PG8_LAS __attribute__((address_space(3)))
typedef unsigned short bf16_t;
typedef short bf16x8 __attribute__((ext_vector_type(8)));
typedef float f32x4 __attribute__((ext_vector_type(4)));
typedef unsigned u32x4 __attribute__((ext_vector_type(4)));
constexpr int BM = 256, BK = 64, HALF = 128, HTB = HALF * BK * 2  , STAGE_BYTES = 8 * HTB, NXCD = 8, WGM = 8;

__host__ __device__ __forceinline__ int lds_byte(int r, int c) { const int st = (r >> 4) * 2 + (c >> 5), rr = r & 15, cc = c & 31, ob = rr * 64 + cc * 2; return st * 1024 + (ob ^ (((ob >> 9) & 1) << 5)); }
__host__ __device__ __forceinline__ void stage_rc(int b, int& R, int& C) { const int st = b / 1024, sb = b % 1024, swz = sb ^ (((sb >> 9) & 1) << 5); R = (st >> 1) * 16 + swz / 64; C = (st & 1) * 32 + (swz % 64) / 2; }
__host__ __device__ __forceinline__ int perm32(int rho) { const int n = rho >> 4, i = rho & 15; return 8 * (i >> 2) + 4 * n + (i & 3); }

struct Unit { int pm, pn; };
struct Gemm { const bf16_t* A; const bf16_t* Bt; int M, N, K; };

struct StaticOrder {
    int nM, nN, nwg, G, c;
    __host__ __device__ void init(int M, int N, int G_, int c_) { nM = M / BM; nN = N / BM; nwg = nM * nN; G = G_; c = c_; }
    __host__ __device__ bool next(int i, Unit& u) const {
        const long L = (long)i * G + c; if (L >= nwg) return false;
        int wgid = (int)L; { const int q = nwg / NXCD, r = nwg % NXCD, xcd = wgid % NXCD, off = wgid / NXCD; wgid = (xcd < r ? xcd * (q + 1) : r * (q + 1) + (xcd - r) * q) + off; }
        const int nig = WGM * nN, gid = wgid / nig, fm = gid * WGM, gsz = (nM - fm) < WGM ? (nM - fm) : WGM;
        u.pm = fm + ((wgid % nig) % gsz); u.pn = (wgid % nig) / gsz; return true;
    }
    __device__ __forceinline__ void a_ready(const Unit&) const {}
    __device__ __forceinline__ void done(const Unit&) const {}
};

__device__ __forceinline__ unsigned cvt_pk_bf16(float lo, float hi) { unsigned r; asm volatile("s_nop 1\n\tv_cvt_pk_bf16_f32 %0, %1, %2\n\ts_nop 1" : "=v"(r) : "v"(lo), "v"(hi)); return r; }
typedef float f32x2 __attribute__((ext_vector_type(2)));
template <class Epi, class Sched, bool ALIGN_EPI = false, bool SP2 = false>
__device__ __forceinline__ void gemm_phase(PG8_LAS unsigned char* lds, const Gemm g, const Sched& S, const Epi& E, const int tid_in) {
    const int tid = tid_in, wid = __builtin_amdgcn_readfirstlane(tid >> 6), lane = tid & 63, wr = wid >> 2, wc = wid & 3, fr = lane & 15, fq = lane >> 4;
    const int K = g.K, nt = K / BK;
    unsigned voffA[2], voffB[2];
#pragma unroll
    for (int i = 0; i < 2; ++i) { int R, C; stage_rc(tid * 16 + i * 8192, R, C); const int Rb = Epi::PERM ? ((R & ~31) + perm32(R & 31)) : R;
        voffA[i] = (unsigned)(R * K + C) * 2u; voffB[i] = (unsigned)(Rb * K + C) * 2u; }
    const size_t kstep = (size_t)(BK * 2);
    const size_t hstep = (size_t)HALF * K * 2;
    const size_t tstep = 2 * hstep;
    const unsigned ldsw = (unsigned)wid * 1024u;
    const int aoff = lds_byte(wr * 64 + fr, fq * 8), boff = lds_byte(wc * 32 + fr, fq * 8);
#define PG8_SA(b, h) (((b) * 2 + (h)) * HTB)
#define PG8_SB(b, h) ((4 + (b) * 2 + (h)) * HTB)
#define PG8_STAGE(bufoff, gbase, voff) do { _Pragma("unroll") for (int _i = 0; _i < 2; ++_i) \
        __builtin_amdgcn_global_load_lds((const unsigned*)((const char*)(gbase) + (voff)[_i]), (PG8_LAS unsigned*)(lds + (bufoff) + ldsw + _i * 8192), 16, 0, 0); } while (0)
#define PG8_LDA(dst, b, h) do { _Pragma("unroll") for (int m = 0; m < 4; ++m) _Pragma("unroll") for (int k = 0; k < 2; ++k) dst[m][k] = *(const PG8_LAS bf16x8*)(lds + PG8_SA(b, h) + aoff + m * 2048 + k * 1024); } while (0)
#define PG8_LDB(dst, b, h) do { _Pragma("unroll") for (int n = 0; n < 2; ++n) _Pragma("unroll") for (int k = 0; k < 2; ++k) dst[n][k] = *(const PG8_LAS bf16x8*)(lds + PG8_SB(b, h) + boff + n * 2048 + k * 1024); } while (0)
#define PG8_MMA(ai, bj, At, Bt) do { __builtin_amdgcn_s_setprio(1); _Pragma("unroll") for (int m = 0; m < 4; ++m) _Pragma("unroll") for (int n = 0; n < 2; ++n) _Pragma("unroll") for (int k = 0; k < 2; ++k) \
        acc[ai][bj][m][n] = __builtin_amdgcn_mfma_f32_16x16x32_bf16(Bt[n][k], At[m][k], acc[ai][bj][m][n], 0, 0, 0); __builtin_amdgcn_s_setprio(0); } while (0)
#define PG8_WAIT_V(n) asm volatile("s_waitcnt vmcnt(" #n ")" ::: "memory")
#define PG8_WAIT_L(n) asm volatile("s_waitcnt lgkmcnt(" #n ")" ::: "memory")
#define PG8_BAR __builtin_amdgcn_s_barrier()
#define PG8_SCHED __builtin_amdgcn_sched_barrier(0)
    Unit cur, nxt; int ui = 0;
    if (!S.next(0, cur)) return;
    f32x4 acc[2][2][4][2];
#pragma unroll
    for (int a = 0; a < 2; ++a)
#pragma unroll
        for (int b = 0; b < 2; ++b)
#pragma unroll
            for (int m = 0; m < 4; ++m)
#pragma unroll
                for (int n = 0; n < 2; ++n) acc[a][b][m][n] = (f32x4){0.f, 0.f, 0.f, 0.f};
    bf16x8 At[4][2], B0[2][2], B1[2][2];
    const char* cA = (const char*)g.A + (size_t)cur.pm * tstep; const char* cB = (const char*)g.Bt + (size_t)cur.pn * tstep;
    S.a_ready(cur);
    if constexpr (SP2) {
        PG8_STAGE(PG8_SB(0, 0), cB, voffB); PG8_STAGE(PG8_SB(0, 1), cB + hstep, voffB); PG8_STAGE(PG8_SA(0, 0), cA, voffA); PG8_STAGE(PG8_SA(0, 1), cA + hstep, voffA);
        if (wr == 1) PG8_BAR;
        PG8_WAIT_V(2); PG8_BAR;
        PG8_STAGE(PG8_SB(1, 0), cB + kstep, voffB); PG8_STAGE(PG8_SA(1, 0), cA + kstep, voffA); PG8_STAGE(PG8_SB(1, 1), cB + hstep + kstep, voffB);
        PG8_WAIT_V(6); PG8_BAR;
    } else {
        PG8_STAGE(PG8_SB(0, 0), cB, voffB); PG8_STAGE(PG8_SA(0, 0), cA, voffA); PG8_STAGE(PG8_SB(0, 1), cB + hstep, voffB); PG8_STAGE(PG8_SA(0, 1), cA + hstep, voffA);
        if (wr == 1) PG8_BAR;
        PG8_WAIT_V(4); PG8_BAR;
        PG8_STAGE(PG8_SB(1, 0), cB + kstep, voffB); PG8_STAGE(PG8_SA(1, 0), cA + kstep, voffA); PG8_STAGE(PG8_SB(1, 1), cB + hstep + kstep, voffB);
        PG8_WAIT_V(6); PG8_BAR;
    }
    for (;;) {
        const bool has_next = S.next(ui + 1, nxt);
        const char* nA = has_next ? (const char*)g.A + (size_t)nxt.pm * tstep : cA; const char* nB = has_next ? (const char*)g.Bt + (size_t)nxt.pn * tstep : cB;
        for (int t = 0; t < nt; t += 2) {
            const bool last = (t == nt - 2);
            const char* a1 = cA + (size_t)(t + 1) * kstep;
            const char* a2 = last ? nA : cA + (size_t)(t + 2) * kstep; const char* b2 = last ? nB : cB + (size_t)(t + 2) * kstep;
            const char* a3 = a2 + kstep; const char* b3 = b2 + kstep;
            if (last && has_next) S.a_ready(nxt);
            if constexpr (SP2) {
            PG8_LDB(B0, 0, 0); PG8_LDB(B1, 0, 1); PG8_SCHED; PG8_LDA(At, 0, 0); PG8_STAGE(PG8_SA(1, 1), a1 + hstep, voffA);
            PG8_WAIT_V(8); PG8_WAIT_L(0); PG8_BAR; PG8_MMA(0, 0, At, B0); PG8_MMA(0, 1, At, B1); PG8_BAR; PG8_SCHED;
            PG8_LDA(At, 0, 1); PG8_STAGE(PG8_SB(0, 0), b2, voffB); PG8_STAGE(PG8_SB(0, 1), b2 + hstep, voffB); PG8_STAGE(PG8_SA(0, 0), a2, voffA);
            PG8_WAIT_V(8); PG8_WAIT_L(0); PG8_BAR; PG8_MMA(1, 0, At, B0); PG8_MMA(1, 1, At, B1); PG8_BAR; PG8_SCHED;
            PG8_LDB(B0, 1, 0); PG8_LDB(B1, 1, 1); PG8_SCHED; PG8_LDA(At, 1, 0); PG8_STAGE(PG8_SA(0, 1), a2 + hstep, voffA);
            PG8_WAIT_V(8); PG8_WAIT_L(0); PG8_BAR; PG8_MMA(0, 0, At, B0); PG8_MMA(0, 1, At, B1); PG8_BAR; PG8_SCHED;
            PG8_LDA(At, 1, 1); PG8_STAGE(PG8_SB(1, 0), b3, voffB); PG8_STAGE(PG8_SB(1, 1), b3 + hstep, voffB); PG8_STAGE(PG8_SA(1, 0), a3, voffA);
            PG8_WAIT_V(8); PG8_WAIT_L(0); PG8_BAR; PG8_MMA(1, 0, At, B0); PG8_MMA(1, 1, At, B1); PG8_BAR; PG8_SCHED;
            } else {
            PG8_LDB(B0, 0, 0); PG8_SCHED; PG8_LDA(At, 0, 0); PG8_STAGE(PG8_SA(1, 1), a1 + hstep, voffA);
            PG8_WAIT_L(8); PG8_BAR; PG8_WAIT_L(0); PG8_MMA(0, 0, At, B0); PG8_BAR; PG8_SCHED;
            PG8_LDB(B1, 0, 1); PG8_STAGE(PG8_SB(0, 0), b2, voffB);
            PG8_BAR; PG8_WAIT_L(0); PG8_MMA(0, 1, At, B1); PG8_BAR;
            PG8_LDA(At, 0, 1); PG8_STAGE(PG8_SA(0, 0), a2, voffA);
            PG8_BAR; PG8_WAIT_L(0); PG8_MMA(1, 0, At, B0); PG8_BAR; PG8_SCHED;
            PG8_STAGE(PG8_SB(0, 1), b2 + hstep, voffB);
            PG8_WAIT_V(6); PG8_BAR; PG8_MMA(1, 1, At, B1); PG8_BAR;
            PG8_LDB(B0, 1, 0); PG8_SCHED; PG8_LDA(At, 1, 0); PG8_STAGE(PG8_SA(0, 1), a2 + hstep, voffA);
            PG8_WAIT_L(8); PG8_BAR; PG8_WAIT_L(0); PG8_MMA(0, 0, At, B0); PG8_BAR; PG8_SCHED;
            PG8_LDB(B1, 1, 1); PG8_STAGE(PG8_SB(1, 0), b3, voffB);
            PG8_BAR; PG8_WAIT_L(0); PG8_MMA(0, 1, At, B1); PG8_BAR;
            PG8_LDA(At, 1, 1); PG8_STAGE(PG8_SA(1, 0), a3, voffA);
            PG8_BAR; PG8_WAIT_L(0); PG8_MMA(1, 0, At, B0); PG8_BAR; PG8_SCHED;
            PG8_STAGE(PG8_SB(1, 1), b3 + hstep, voffB);
            PG8_WAIT_V(6); PG8_BAR; PG8_MMA(1, 1, At, B1); PG8_BAR;
            }
        }
        if constexpr (ALIGN_EPI) { if (wr == 0) PG8_BAR; }
        if constexpr (!Epi::AFTER_DRAIN) { E(acc, cur, wr, wc, fr, fq); S.done(cur); }
        if (!has_next) break;
#pragma unroll
        for (int a = 0; a < 2; ++a)
#pragma unroll
            for (int b = 0; b < 2; ++b)
#pragma unroll
                for (int m = 0; m < 4; ++m)
#pragma unroll
                    for (int n = 0; n < 2; ++n) acc[a][b][m][n] = (f32x4){0.f, 0.f, 0.f, 0.f};
        cur = nxt; cA = nA; cB = nB; ++ui;
        if constexpr (ALIGN_EPI) { if (wr == 1) PG8_BAR; }
    }
    PG8_WAIT_V(0);
    if constexpr (!ALIGN_EPI) { if (wr == 0) PG8_BAR; }
    PG8_BAR;
    if constexpr (Epi::AFTER_DRAIN) { E.fused(acc, cur, wr, wc, fr, fq, lds, wid, lane); S.done(cur); }
#undef PG8_SA
#undef PG8_SB
#undef PG8_STAGE
#undef PG8_LDA
#undef PG8_LDB
#undef PG8_MMA
#undef PG8_WAIT_V
#undef PG8_WAIT_L
#undef PG8_BAR
#undef PG8_SCHED
}
}
#define GAS __attribute__((address_space(1)))
#define LAS __attribute__((address_space(3)))
typedef unsigned short bf16;
typedef unsigned v4u __attribute__((ext_vector_type(4)));
typedef float f32x4 __attribute__((ext_vector_type(4)));
typedef short bf16x8 __attribute__((ext_vector_type(8)));
typedef GAS unsigned gu32;
typedef GAS unsigned long long gu64;
#define RLX_AGENT __ATOMIC_RELAXED, __HIP_MEMORY_SCOPE_AGENT
#define LDS_WAIT() asm volatile("s_waitcnt lgkmcnt(0)" ::: "memory")
#define VM_WAIT() asm volatile("s_waitcnt vmcnt(0)" ::: "memory")
__device__ __forceinline__ unsigned long long rt() { return __builtin_amdgcn_s_memrealtime(); }
__device__ __forceinline__ unsigned f2bf(float f) { unsigned u = __builtin_bit_cast(unsigned, f); return (u + 0x7fffu + ((u >> 16) & 1u)) >> 16; }
__device__ __forceinline__ unsigned pk2(float lo, float hi) { return f2bf(lo) | (f2bf(hi) << 16); }
#define XB_TMO      128
#define XB_XCNT(j)  (256  + 64 * (j))
#define XB_XSUB(j)  (1280 + 64 * (j))
#define XB_XGEN(j)  (2304 + 64 * (j))
#define XB_TOP      3328
#define XB_TOPGEN   3392
#define XCD_BAR_WORDS 3456
#define XB_SPIN_CAP (1u << 18)

__device__ __forceinline__ unsigned xb_ld(unsigned* p)              { return __hip_atomic_load(p, __ATOMIC_RELAXED, __HIP_MEMORY_SCOPE_AGENT); }
__device__ __forceinline__ unsigned xb_add(unsigned* p, unsigned v) { return __hip_atomic_fetch_add(p, v, __ATOMIC_RELAXED, __HIP_MEMORY_SCOPE_AGENT); }
__device__ __forceinline__ unsigned xb_xcc_id() { return (unsigned)__builtin_amdgcn_s_getreg((3 << 11) | 20) & 0xFu; }
#define XB_SPIN(cond, bar) do { unsigned _sp = 0; while (cond) { __builtin_amdgcn_s_sleep(1); \
    if ((++_sp & 255u) == 0u) { if (xb_ld(&(bar)[XB_TMO])) break; if (_sp > XB_SPIN_CAP) { atomicAdd(&(bar)[XB_TMO], 1u); break; } } } } while (0)

struct XcdBarrier {
    unsigned* bar; unsigned x;
    volatile LAS unsigned* st;
};

__device__ __forceinline__ XcdBarrier xcd_barrier_post(unsigned* bar, volatile LAS unsigned* st, bool leader) {
    XcdBarrier b; b.bar = bar; b.x = xb_xcc_id(); b.st = st;
    if (leader) (void)xb_add(&bar[XB_XCNT(b.x)], 1u);
    return b;
}
__device__ __forceinline__ void xcd_barrier_complete(unsigned* bar, unsigned x, unsigned& nloc, unsigned& nx) {
    const unsigned G = gridDim.x * gridDim.y * gridDim.z;
    unsigned sum, cnt, mine, sp = 0u;
    for (;;) {
        sum = 0u; cnt = 0u; mine = 0u;
#pragma unroll
        for (unsigned j = 0; j < 16; ++j) { const unsigned c = xb_ld(&bar[XB_XCNT(j)]); sum += c; cnt += (c > 0u) ? 1u : 0u; mine = (j == x) ? c : mine; }
        if (sum == G) break;
        __builtin_amdgcn_s_sleep(1);
        if ((++sp & 255u) == 0u) { if (xb_ld(&bar[XB_TMO])) break; if (sp > XB_SPIN_CAP) { atomicAdd(&bar[XB_TMO], 1u); break; } }
    }
    nloc = mine > 0u ? mine : 1u; nx = cnt > 0u ? cnt : 1u;
}

__device__ __forceinline__ void xcd_barrier(const XcdBarrier& b, bool leader) {
    asm volatile("s_waitcnt vmcnt(0)" ::: "memory");
    __syncthreads();
    if (leader) {
        unsigned* bar = b.bar;
        __builtin_amdgcn_s_waitcnt(0);
        unsigned nloc = b.st[0], nx = b.st[1];
        if (nloc == 0u) { xcd_barrier_complete(bar, b.x, nloc, nx); b.st[0] = nloc; b.st[1] = nx; }
        const unsigned old = xb_add(&bar[XB_XSUB(b.x)], 1u);
        const unsigned gen = old / nloc;
        if (old + 1u == (gen + 1u) * nloc) {
            __builtin_amdgcn_fence(__ATOMIC_RELEASE, "agent");
            asm volatile("s_waitcnt vmcnt(0)" ::: "memory");
            const unsigned og = xb_add(&bar[XB_TOP], 1u);
            const unsigned tg = og / nx;
            if (og + 1u == (tg + 1u) * nx) xb_add(&bar[XB_TOPGEN], 1u);
            else XB_SPIN(xb_ld(&bar[XB_TOPGEN]) == tg, bar);
            __builtin_amdgcn_fence(__ATOMIC_ACQUIRE, "agent");
            asm volatile("s_waitcnt vmcnt(0)" ::: "memory");
        } else {
            XB_SPIN(xb_ld(&bar[XB_TOPGEN]) == gen, bar);
            __builtin_amdgcn_fence(__ATOMIC_ACQUIRE, "agent");
            asm volatile("s_waitcnt vmcnt(0)" ::: "memory");
        }
    }
    __syncthreads();
}
namespace fk {
using pg8::bf16_t; using pg8::f32x4; using pg8::bf16x8; using pg8::u32x4; using pg8::Unit; using pg8::cvt_pk_bf16;
typedef float f32x16 __attribute__((ext_vector_type(16)));
typedef unsigned u32x2 __attribute__((ext_vector_type(2)));
typedef float f32x2 __attribute__((ext_vector_type(2)));
#define FLAS __attribute__((address_space(3)))

constexpr int D = 1024, NB = 8, T = 2048, MP = 16384, MS = 128, R = 16512, MT = 16640, FF = 2816, NMEM = 256;
constexpr float EPS = 1e-6f;
constexpr float QSCALE = 0.0625f * 1.4426950408889634f;
constexpr int NWAVES = 8, NTHR = 512;
constexpr int S5L = 128, S5NC = T / S5L;

constexpr size_t MiB = 1u << 20;
constexpr size_t WS_CTL = 0, CTL_ZERO_BYTES = 32 * 1024;
constexpr size_t WS_LAM = 1 * MiB;
constexpr size_t WS_LAMP = WS_LAM + 32768;
constexpr size_t WS_BB = WS_LAMP + 32768;
constexpr size_t WS_CP = WS_BB + 262144;
constexpr size_t WS_LB = WS_CP + 327680;
constexpr size_t WS_SSQ = 3 * MiB;
constexpr size_t WS_SSQS = WS_SSQ + (size_t)MT * 32 * 4;
constexpr size_t WS_E = 6 * MiB;
constexpr size_t WS_BT = 10 * MiB;
constexpr size_t WS_DBG = 11 * MiB;
constexpr size_t WS_W1IN = 12 * MiB, W1IN_SZ = (size_t)2 * FF * D * 2;
constexpr size_t WS_W1OUT = 34 * MiB, W1OUT_SZ = (size_t)D * FF * 2;
constexpr size_t WS_W2IN = 45 * MiB, WS_W2OUT = 67 * MiB;
constexpr size_t WS_WQ = 78 * MiB, WS_WO = 82 * MiB, WQ_SZ = (size_t)D * D * 2;
constexpr size_t WS_WKV = 86 * MiB, WS_WGLU = 94 * MiB, WS_WHGIN = 98 * MiB, WS_WHGOUT = 106 * MiB;
constexpr size_t WS_MEMN = 108 * MiB, WS_KBM = 112 * MiB, WS_VTM = 120 * MiB;
constexpr size_t WS_X = 128 * MiB, WS_XB = 193 * MiB, WS_AB = 226 * MiB, WS_QB = 259 * MiB, WS_GH = 292 * MiB;
constexpr size_t WS_VT = 325 * MiB  , WS_LOGF = 358 * MiB, WS_SST = 423 * MiB, WS_HB = 487 * MiB, WS_SLOC = 487 * MiB;
constexpr size_t WS_FAST_END = 615 * MiB;
static_assert(WS_W1IN + 2 * W1IN_SZ <= WS_W1OUT && WS_W1OUT + 2 * W1OUT_SZ <= WS_W2IN && WS_W2IN + 2 * W1IN_SZ <= WS_W2OUT && WS_W2OUT + 2 * W1OUT_SZ <= WS_WQ, "ws map");
static_assert(WS_X + (size_t)MT * D * 4 <= WS_XB && WS_XB + (size_t)MT * D * 2 <= WS_AB && WS_HB + (size_t)MT * FF * 2 <= WS_FAST_END && WS_SLOC + (size_t)2048 * 16384 * 4 <= WS_FAST_END, "ws map 2");
static_assert(WS_LOGF + (size_t)MT * D * 4 <= WS_SST && WS_SST + (size_t)2048 * 16384 * 2 <= WS_HB && WS_SSQS + 128 * 64 * 4 <= WS_E, "ws map 3");
constexpr size_t O_Y = 0, O_S5RE_P = (size_t)R * D, O_S5IM_P = O_S5RE_P + 32768, O_S5RE_S = O_S5IM_P + 32768, O_S5IM_S = O_S5RE_S + 524288,
                 O_HG_P = O_S5IM_S + 524288, O_HG_S = O_HG_P + 1048576, O_MK = O_HG_S + 16777216, O_MV = O_MK + 4194304, O_END = O_MV + 4194304;
static_assert(O_END == 44236800, "out size");

constexpr int RING_BYTES = 131072, LDSCTL_OFF = 133120  , MISC_OFF = LDSCTL_OFF + 320, LDS_BYTES = 147456;

__device__ __forceinline__ float fast_exp(float x) { return __builtin_amdgcn_exp2f(x * 1.4426950408889634f); }
__device__ __forceinline__ float fast_rcp(float x) { return __builtin_amdgcn_rcpf(x); }
__device__ __forceinline__ float silu_f(float x) { return x * fast_rcp(1.0f + fast_exp(-x)); }
__device__ __forceinline__ float sigm_f(float x) { return fast_rcp(1.0f + fast_exp(-x)); }
__device__ __forceinline__ unsigned f2bf(float f) { unsigned u = __builtin_bit_cast(unsigned, f); return (u + 0x7fffu + ((u >> 16) & 1u)) >> 16; }
__device__ __forceinline__ unsigned pk2(float lo, float hi) { return cvt_pk_bf16(lo, hi); }
__device__ __forceinline__ float bf2f(unsigned short b) { return __builtin_bit_cast(float, (unsigned)b << 16); }
__device__ __forceinline__ float bflo(unsigned w) { return __builtin_bit_cast(float, w << 16); }
__device__ __forceinline__ float bfhi(unsigned w) { return __builtin_bit_cast(float, w & 0xffff0000u); }
__device__ __forceinline__ float wave_sum(float v) {
#pragma unroll
    for (int o = 1; o < 64; o <<= 1) v += __shfl_xor(v, o);
    return v;
}
__device__ __forceinline__ void st16_wt(void* base  , size_t byte_off, u32x4 v) {
    __amdgpu_buffer_rsrc_t r = __builtin_amdgcn_make_buffer_rsrc(base, 0, 0x7fffffff, 0x00020000);
    __builtin_amdgcn_raw_buffer_store_b128(v, r, (int)(unsigned)byte_off, 0, 16);
}
template <int NP> __device__ __forceinline__ float row_rstd(const float* __restrict__ ssq, int row) {
    const f32x4* p = (const f32x4*)(ssq + (size_t)row * 32); float s = 0.f;
#pragma unroll
    for (int i = 0; i < NP / 4; ++i) { const f32x4 v = p[i]; s += (v[0] + v[1]) + (v[2] + v[3]); }
    return 1.0f / sqrtf(s * (1.0f / D) + EPS);
}

template <int NP> __device__ __forceinline__ void tile_rstd8(const float* __restrict__ ssq, int pm, int wr, int fr, int fq, float (&rs)[2][4]) {
    f32x4 p[2][4][NP / 16];
#pragma unroll
    for (int ai = 0; ai < 2; ++ai)
#pragma unroll
        for (int m = 0; m < 4; ++m)
#pragma unroll
            for (int j = 0; j < NP / 16; ++j) p[ai][m][j] = *(const f32x4*)(ssq + (size_t)(pm * 256 + ai * 128 + wr * 64 + m * 16 + fr) * 32 + 4 * fq + 16 * j);
    __builtin_amdgcn_sched_barrier(0);
#pragma unroll
    for (int ai = 0; ai < 2; ++ai)
#pragma unroll
        for (int m = 0; m < 4; ++m) { float a = 0.f;
#pragma unroll
            for (int j = 0; j < NP / 16; ++j) a += (p[ai][m][j][0] + p[ai][m][j][1]) + (p[ai][m][j][2] + p[ai][m][j][3]);
            a += __shfl_xor(a, 16); a += __shfl_xor(a, 32);
            rs[ai][m] = 1.0f / sqrtf(a * (1.0f / D) + EPS); }
}
#define EPI_ROWS_BEGIN  _Pragma("unroll") for (int ai = 0; ai < 2; ++ai) _Pragma("unroll") for (int m = 0; m < 4; ++m) { const int row = u.pm * 256 + ai * 128 + wr * 64 + m * 16 + fr;
#define EPI_ROWS_END    }

template <int NP> struct EpiSwiglu {
    static constexpr bool PERM = true, AFTER_DRAIN = false;
    const float* ssq; bf16_t* H;
    __device__ __forceinline__ void operator()(const f32x4 (&acc)[2][2][4][2], const Unit& u, int wr, int wc, int fr, int fq) const {
        const int col0 = u.pn * 128 + wc * 32 + 8 * fq;
        float rsv[2][4]; tile_rstd8<NP>(ssq, u.pm, wr, fr, fq, rsv);
        EPI_ROWS_BEGIN
            const float rs = rsv[ai][m];
            float h[8];
#pragma unroll
            for (int n = 0; n < 2; ++n)
#pragma unroll
                for (int i = 0; i < 4; ++i) { const float g = acc[ai][0][m][n][i] * rs, up = acc[ai][1][m][n][i] * rs; h[4 * n + i] = silu_f(g) * up; }
            u32x4 w; w.x = pk2(h[0], h[1]); w.y = pk2(h[2], h[3]); w.z = pk2(h[4], h[5]); w.w = pk2(h[6], h[7]);
            st16_wt(H, ((size_t)row * FF + col0) * 2, w);
        EPI_ROWS_END
    }
};
__device__ __forceinline__ void bf8_to_f32(const u32x4 w, f32x4& lo, f32x4& hi) { lo = (f32x4){bflo(w.x), bfhi(w.x), bflo(w.y), bfhi(w.y)}; hi = (f32x4){bflo(w.z), bfhi(w.z), bflo(w.w), bfhi(w.w)}; }
struct EpiResid {
    static constexpr bool PERM = true, AFTER_DRAIN = false;
    bf16_t* XB; float* ssq; float scale;
    __device__ __forceinline__ void operator()(const f32x4 (&acc)[2][2][4][2], const Unit& u, int wr, int wc, int fr, int fq) const {
#pragma unroll
        for (int ai = 0; ai < 2; ++ai) {
            u32x4 xv[4][2];
#pragma unroll
            for (int m = 0; m < 4; ++m)
#pragma unroll
                for (int bj = 0; bj < 2; ++bj) xv[m][bj] = *(const u32x4*)(XB + (size_t)(u.pm * 256 + ai * 128 + wr * 64 + m * 16 + fr) * D + u.pn * 256 + bj * 128 + wc * 32 + 8 * fq);
            __builtin_amdgcn_sched_barrier(0);
#pragma unroll
            for (int m = 0; m < 4; ++m) { const int row = u.pm * 256 + ai * 128 + wr * 64 + m * 16 + fr;
                float sq = 0.f;
#pragma unroll
                for (int bj = 0; bj < 2; ++bj) {
                    const size_t off = (size_t)row * D + u.pn * 256 + bj * 128 + wc * 32 + 8 * fq;
                    f32x4 x0, x1; bf8_to_f32(xv[m][bj], x0, x1);
                    x0 = x0 + acc[ai][bj][m][0] * scale; x1 = x1 + acc[ai][bj][m][1] * scale;
                    u32x4 w; w.x = pk2(x0[0], x0[1]); w.y = pk2(x0[2], x0[3]); w.z = pk2(x1[0], x1[1]); w.w = pk2(x1[2], x1[3]);
                    st16_wt(XB, off * 2, w);
                    bf8_to_f32(w, x0, x1);
                    sq += (x0[0] * x0[0] + x0[1] * x0[1]) + (x0[2] * x0[2] + x0[3] * x0[3]) + (x1[0] * x1[0] + x1[1] * x1[1]) + (x1[2] * x1[2] + x1[3] * x1[3]);
                }
                sq += __shfl_xor(sq, 16); sq += __shfl_xor(sq, 32);
                if (fq == 0) ssq[(size_t)row * 32 + u.pn * 4 + wc] = sq; }
            __builtin_amdgcn_sched_barrier(0);
        }
    }
};
struct EpiGlu {
    static constexpr bool PERM = true, AFTER_DRAIN = false;
    bf16_t* XB; float* ssq;
    __device__ __forceinline__ void operator()(const f32x4 (&acc)[2][2][4][2], const Unit& u, int wr, int wc, int fr, int fq) const {
        u32x4 xv[2][4];
#pragma unroll
        for (int ai = 0; ai < 2; ++ai)
#pragma unroll
            for (int m = 0; m < 4; ++m) xv[ai][m] = *(const u32x4*)(XB + (size_t)(u.pm * 256 + ai * 128 + wr * 64 + m * 16 + fr) * D + u.pn * 128 + wc * 32 + 8 * fq);
        __builtin_amdgcn_sched_barrier(0);
        EPI_ROWS_BEGIN
            const size_t off = (size_t)row * D + u.pn * 128 + wc * 32 + 8 * fq;
            f32x4 x0, x1; bf8_to_f32(xv[ai][m], x0, x1);
#pragma unroll
            for (int i = 0; i < 4; ++i) { x0[i] += acc[ai][0][m][0][i] * sigm_f(acc[ai][1][m][0][i]); x1[i] += acc[ai][0][m][1][i] * sigm_f(acc[ai][1][m][1][i]); }
            u32x4 w; w.x = pk2(x0[0], x0[1]); w.y = pk2(x0[2], x0[3]); w.z = pk2(x1[0], x1[1]); w.w = pk2(x1[2], x1[3]);
            *(u32x4*)(XB + off) = w;
            bf8_to_f32(w, x0, x1);
            float sq = (x0[0] * x0[0] + x0[1] * x0[1]) + (x0[2] * x0[2] + x0[3] * x0[3]) + (x1[0] * x1[0] + x1[1] * x1[1]) + (x1[2] * x1[2] + x1[3] * x1[3]);
            sq += __shfl_xor(sq, 16); sq += __shfl_xor(sq, 32);
            if (fq == 0) ssq[(size_t)row * 32 + u.pn * 4 + wc] = sq;
        EPI_ROWS_END
    }
};
template <int NP> struct EpiQ {
    static constexpr bool PERM = true, AFTER_DRAIN = false;
    const float* ssq; bf16_t* Q;
    __device__ __forceinline__ void operator()(const f32x4 (&acc)[2][2][4][2], const Unit& u, int wr, int wc, int fr, int fq) const {
        float rsv[2][4]; tile_rstd8<NP>(ssq, u.pm, wr, fr, fq, rsv);
        EPI_ROWS_BEGIN
            const float rs = rsv[ai][m] * QSCALE;
#pragma unroll
            for (int bj = 0; bj < 2; ++bj) {
                const size_t off = (size_t)row * D + u.pn * 256 + bj * 128 + wc * 32 + 8 * fq;
                const f32x4 a = acc[ai][bj][m][0] * rs, b = acc[ai][bj][m][1] * rs;
                u32x4 w; w.x = pk2(a[0], a[1]); w.y = pk2(a[2], a[3]); w.z = pk2(b[0], b[1]); w.w = pk2(b[2], b[3]);
                *(u32x4*)(Q + off) = w;
            }
        EPI_ROWS_END
    }
};
__device__ __forceinline__ int perm16pos(int m) { return (m & ~12) | ((m & 4) << 1) | ((m & 8) >> 1); }
struct EpiMemKV {
    static constexpr bool PERM = true, AFTER_DRAIN = false;
    float* out; bf16_t* KB; bf16_t* VT;
    __device__ __forceinline__ void operator()(const f32x4 (&acc)[2][2][4][2], const Unit& u, int wr, int wc, int fr, int fq) const {
        const int layer = u.pn >> 3, kv = (u.pn >> 2) & 1, jt = (u.pn & 3) * 256;
        EPI_ROWS_BEGIN
#pragma unroll
            for (int bj = 0; bj < 2; ++bj) {
                const int j = jt + bj * 128 + wc * 32 + 8 * fq;
                const f32x4 a = acc[ai][bj][m][0], b = acc[ai][bj][m][1];
                float* o = out + (kv ? O_MV : O_MK) + ((size_t)layer * 2048 + row) * D + j;
                __builtin_nontemporal_store(a, (f32x4*)o); __builtin_nontemporal_store(b, (f32x4*)(o + 4));
                if (kv == 0) { u32x4 w; w.x = pk2(a[0], a[1]); w.y = pk2(a[2], a[3]); w.z = pk2(b[0], b[1]); w.w = pk2(b[2], b[3]);
                    *(u32x4*)(KB + ((size_t)layer * 2048 + row) * D + j) = w; }
                else {
                    const int bb = row >> 8, mm = row & 255, hh = j >> 8, dv = j & 255;
                    bf16_t* vt = VT + ((((size_t)layer * 8 + bb) * 4 + hh) * 256 + dv) * 256 + perm16pos(mm);
#pragma unroll
                    for (int i = 0; i < 4; ++i) { vt[(size_t)i * 256] = (bf16_t)f2bf(a[i]); vt[(size_t)(4 + i) * 256] = (bf16_t)f2bf(b[i]); }
                }
            }
        EPI_ROWS_END
    }
};
template <int NP> struct EpiHgIn {
    static constexpr bool PERM = true, AFTER_DRAIN = false;
    const float* ssq; const float* lb; bf16_t* QH; float* LOGF; bf16_t* VN; bf16_t* GH;
    __device__ __forceinline__ void operator()(const f32x4 (&acc)[2][2][4][2], const Unit& u, int wr, int wc, int fr, int fq) const {
        const int sec = u.pn >> 2, jt = (u.pn & 3) * 256;
        float rsv[2][4]; tile_rstd8<NP>(ssq, u.pm, wr, fr, fq, rsv);
        f32x4 lbv[2][2];
#pragma unroll
        for (int bj = 0; bj < 2; ++bj) { const int j = jt + bj * 128 + wc * 32 + 8 * fq; lbv[bj][0] = *(const f32x4*)(lb + j); lbv[bj][1] = *(const f32x4*)(lb + j + 4); }
        EPI_ROWS_BEGIN
            const float rs = rsv[ai][m];
#pragma unroll
            for (int bj = 0; bj < 2; ++bj) {
                const int j = jt + bj * 128 + wc * 32 + 8 * fq;
                const f32x4 a = acc[ai][bj][m][0] * rs, b = acc[ai][bj][m][1] * rs;
                if (sec == 1) {
                    const f32x4 l0 = lbv[bj][0], l1 = lbv[bj][1];
                    f32x4 o0, o1;
#pragma unroll
                    for (int i = 0; i < 4; ++i) { const float k0 = (1.0f - l0[i]) * fast_rcp(1.0f + fast_exp(a[i])), k1 = (1.0f - l1[i]) * fast_rcp(1.0f + fast_exp(b[i]));
                        o0[i] = __builtin_amdgcn_logf(1.0f - k0) * 0.6931471805599453f; o1[i] = __builtin_amdgcn_logf(1.0f - k1) * 0.6931471805599453f; }
                    *(f32x4*)(LOGF + (size_t)row * D + j) = o0; *(f32x4*)(LOGF + (size_t)row * D + j + 4) = o1;
                } else {
                    float s[8];
#pragma unroll
                    for (int i = 0; i < 4; ++i) { s[i] = sec == 2 ? a[i] : silu_f(a[i]); s[4 + i] = sec == 2 ? b[i] : silu_f(b[i]); }
                    u32x4 w; w.x = pk2(s[0], s[1]); w.y = pk2(s[2], s[3]); w.z = pk2(s[4], s[5]); w.w = pk2(s[6], s[7]);
                    const size_t off = (size_t)row * D + j;
                    if (sec == 0) st16_wt(QH, off * 2, w); else if (sec == 2) st16_wt(VN, off * 2, w); else st16_wt(GH, off * 2, w);
                }
            }
        EPI_ROWS_END
    }
};

__device__ __forceinline__ float srow_rstd(const float* __restrict__ ssqs, int srow) {
    const f32x4* p = (const f32x4*)(ssqs + (size_t)srow * 64); float s = 0.f;
#pragma unroll
    for (int i = 0; i < 16; ++i) { const f32x4 v = p[i]; s += (v[0] + v[1]) + (v[2] + v[3]); }
    return 1.0f / sqrtf(s * (1.0f / D) + EPS);
}
struct SRowPre { f32x4 v[4]; };
__device__ __forceinline__ void srow_rstd4_load(const float* __restrict__ ssqs, int srow0, int cl, SRowPre& P) {
#pragma unroll
    for (int j = 0; j < 4; ++j) P.v[j] = *(const f32x4*)(ssqs + (size_t)(srow0 + j) * 64 + 4 * cl);
}
__device__ __forceinline__ void srow_rstd4_finish(const SRowPre& P, float (&rs)[4]) {
#pragma unroll
    for (int j = 0; j < 4; ++j) { float s = (P.v[j][0] + P.v[j][1]) + (P.v[j][2] + P.v[j][3]);
        s += __shfl_xor(s, 1); s += __shfl_xor(s, 2); s += __shfl_xor(s, 4); s += __shfl_xor(s, 8); rs[j] = 1.0f / sqrtf(s * (1.0f / D) + EPS); }
}
template <bool PAIRED, int KS, int NT, class SEpi>
__device__ __forceinline__ void skinny_unit(const bf16_t* __restrict__ A, const bf16_t* __restrict__ Bt, int u, int wave, int lane, FLAS unsigned char* lds, const SEpi& E) {
    constexpr int K = KS * 128, NB_ = PAIRED ? 2 : 1, NACC = NT * NB_, CH = (KS == 8) ? ((NACC >= 4) ? 4 : 8) : 11, NCH = KS / CH;
    static_assert(KS % CH == 0, "chunking");
    const int cl = lane & 15, kq = lane >> 4, rt = wave & 1, kw = wave >> 1, rb = u & 3, uc = u >> 2;
    const int srow = 32 * rb + 16 * rt;
    const bf16_t* ap = A + (size_t)(MP + srow + cl) * K + kw * (KS * 32) + 8 * kq;
    const bf16_t* bp[NACC];
#pragma unroll
    for (int t = 0; t < NT; ++t) { const int c = 16 * (NT * uc + t) + cl;
        if (PAIRED) { const int rw = (c >> 7) * 256 + (c & 127); bp[2 * t] = Bt + (size_t)rw * K + kw * (KS * 32) + 8 * kq; bp[2 * t + 1] = bp[2 * t] + (size_t)128 * K; }
        else bp[t] = Bt + (size_t)c * K + kw * (KS * 32) + 8 * kq; }
    f32x4 acc[NACC];
#pragma unroll
    for (int i = 0; i < NACC; ++i) acc[i] = (f32x4){0.f, 0.f, 0.f, 0.f};
    typename SEpi::Pre P[NT] = {};
#pragma unroll
    for (int chn = 0; chn < NCH; ++chn) {
        bf16x8 a[CH], b[NACC][CH];
#pragma unroll
        for (int i = 0; i < CH; ++i) { a[i] = *(const bf16x8*)(ap + 32 * (chn * CH + i));
#pragma unroll
            for (int j = 0; j < NACC; ++j) b[j][i] = *(const bf16x8*)(bp[j] + 32 * (chn * CH + i)); }
        if (chn == NCH - 1 && kw == 0) {
#pragma unroll
            for (int t = 0; t < NT; ++t) E.pre(P[t], srow + 4 * kq, 16 * (NT * uc + t) + cl, cl); }
        __builtin_amdgcn_sched_barrier(0);
#pragma unroll
        for (int i = 0; i < CH; ++i)
#pragma unroll
            for (int j = 0; j < NACC; ++j) acc[j] = __builtin_amdgcn_mfma_f32_16x16x32_bf16(a[i], b[j][i], acc[j], 0, 0, 0);
        __builtin_amdgcn_sched_barrier(0);
    }
    FLAS f32x4* red = (FLAS f32x4*)lds;
#pragma unroll
    for (int j = 0; j < NACC; ++j) red[(wave * NACC + j) * 64 + lane] = acc[j];
    asm volatile("s_waitcnt lgkmcnt(0)" ::: "memory"); __builtin_amdgcn_s_barrier(); asm volatile("" ::: "memory");
    if (kw == 0) {
#pragma unroll
        for (int q = 1; q < 4; ++q)
#pragma unroll
            for (int j = 0; j < NACC; ++j) acc[j] = acc[j] + red[((rt + 2 * q) * NACC + j) * 64 + lane];
#pragma unroll
        for (int t = 0; t < NT; ++t) { const f32x4 pr[2] = {acc[NB_ * t], acc[NB_ * t + (NB_ - 1)]}; E(pr, P[t], srow + 4 * kq, 16 * (NT * uc + t) + cl, NT * uc + t, cl); }
    }
    asm volatile("s_waitcnt lgkmcnt(0)" ::: "memory"); __builtin_amdgcn_s_barrier(); asm volatile("" ::: "memory");
}
struct SEpiSwiglu { const float* ssqs; bf16_t* H;
    typedef SRowPre Pre;
    __device__ __forceinline__ void pre(Pre& P, int srow0, int, int cl) const { srow_rstd4_load(ssqs, srow0, cl, P); }
    __device__ __forceinline__ void operator()(const f32x4 (&acc)[2], const Pre& P, int srow0, int col, int, int cl) const {
        float rs[4]; srow_rstd4_finish(P, rs);
#pragma unroll
        for (int j = 0; j < 4; ++j) H[(size_t)(MP + srow0 + j) * FF + col] = (bf16_t)f2bf(silu_f(acc[0][j] * rs[j]) * (acc[1][j] * rs[j])); } };
struct SXbPre { unsigned short xo[4]; };
struct SEpiResid { bf16_t* XB; float* ssqs; float scale;
    typedef SXbPre Pre;
    __device__ __forceinline__ void pre(Pre& P, int srow0, int col, int) const {
#pragma unroll
        for (int j = 0; j < 4; ++j) P.xo[j] = XB[(size_t)(MP + srow0 + j) * D + col]; }
    __device__ __forceinline__ void operator()(const f32x4 (&acc)[2], const Pre& P, int srow0, int col, int u, int cl) const {
        const unsigned short (&xo)[4] = P.xo;
#pragma unroll
        for (int j = 0; j < 4; ++j) { const size_t off = (size_t)(MP + srow0 + j) * D + col; const unsigned short xb_ = (unsigned short)f2bf(bf2f(xo[j]) + scale * acc[0][j]); XB[off] = xb_; const float x = bf2f(xb_); float sq = x * x;
            sq += __shfl_xor(sq, 1); sq += __shfl_xor(sq, 2); sq += __shfl_xor(sq, 4); sq += __shfl_xor(sq, 8);
            if (cl == 0) ssqs[(size_t)(srow0 + j) * 64 + u] = sq; } } };
struct SEpiGlu { bf16_t* XB; float* ssqs;
    typedef SXbPre Pre;
    __device__ __forceinline__ void pre(Pre& P, int srow0, int col, int) const {
#pragma unroll
        for (int j = 0; j < 4; ++j) P.xo[j] = XB[(size_t)(MP + srow0 + j) * D + col]; }
    __device__ __forceinline__ void operator()(const f32x4 (&acc)[2], const Pre& P, int srow0, int col, int u, int cl) const {
        const unsigned short (&xo)[4] = P.xo;
#pragma unroll
        for (int j = 0; j < 4; ++j) { const size_t off = (size_t)(MP + srow0 + j) * D + col; const unsigned short xb_ = (unsigned short)f2bf(bf2f(xo[j]) + acc[0][j] * sigm_f(acc[1][j])); XB[off] = xb_; const float x = bf2f(xb_); float sq = x * x;
            sq += __shfl_xor(sq, 1); sq += __shfl_xor(sq, 2); sq += __shfl_xor(sq, 4); sq += __shfl_xor(sq, 8);
            if (cl == 0) ssqs[(size_t)(srow0 + j) * 64 + u] = sq; } } };
struct SEpiQ { const float* ssqs; bf16_t* Q;
    typedef SRowPre Pre;
    __device__ __forceinline__ void pre(Pre& P, int srow0, int, int cl) const { srow_rstd4_load(ssqs, srow0, cl, P); }
    __device__ __forceinline__ void operator()(const f32x4 (&acc)[2], const Pre& P, int srow0, int col, int, int cl) const {
        float rs[4]; srow_rstd4_finish(P, rs);
#pragma unroll
        for (int j = 0; j < 4; ++j) Q[(size_t)(MP + srow0 + j) * D + col] = (bf16_t)f2bf(acc[0][j] * rs[j] * QSCALE); } };
struct SHgPre { SRowPre r; float lbc; };
struct SEpiHgIn { const float* ssqs; const float* lb; bf16_t* QH; float* LOGF; bf16_t* VN; bf16_t* GH;
    typedef SHgPre Pre;
    __device__ __forceinline__ void pre(Pre& P, int srow0, int col, int cl) const { srow_rstd4_load(ssqs, srow0, cl, P.r); P.lbc = lb[col & 1023]; }
    __device__ __forceinline__ void operator()(const f32x4 (&acc)[2], const Pre& P, int srow0, int col, int u, int cl) const {
        const int sec = u >> 6, c = col & 1023;
        const float lbc = P.lbc;
        float rs[4]; srow_rstd4_finish(P.r, rs);
#pragma unroll
        for (int j = 0; j < 4; ++j) { const size_t off = (size_t)(MP + srow0 + j) * D + c; const float v = acc[0][j] * rs[j];
            if (sec == 0) QH[off] = (bf16_t)f2bf(silu_f(v));
            else if (sec == 1) { const float kk = (1.0f - lbc) * fast_rcp(1.0f + fast_exp(v)); LOGF[off] = __builtin_amdgcn_logf(1.0f - kk) * 0.6931471805599453f; }
            else if (sec == 2) VN[off] = (bf16_t)f2bf(v);
            else GH[off] = (bf16_t)f2bf(silu_f(v)); } } };
struct Args { const float* in[34]; float* out; unsigned char* ws; int ph_lo, ph_hi; };
#define KAS __attribute__((address_space(4)))
struct Frame {
    FLAS unsigned char* lds;
    int tid, lane, wave, vcu, G;
    KAS const char* ka; float* out; unsigned char* ws;
};
static_assert(sizeof(Args) == 296, "Args layout");
#define FIN(i) (*(const float* KAS const*)(F.ka + 8 * (i)))
#define WSP(T_, off) ((T_*)(F.ws + (off)))

constexpr int PREP_WAVE_LDS = 64 * 65 * 4;
__device__ __forceinline__ void prep_transpose_item(const float* __restrict__ W, int K, int N, bf16_t* __restrict__ WT, int mode, int row_off_or_S, const float* __restrict__ gain,
                                                    FLAS float* scr, int item, int lane) {
    const int nblk = N / 64, kb = item / nblk, nb = item % nblk, k0 = 64 * kb, n0 = 64 * nb;
    {   f32x4 v[16]; const int r4 = lane >> 4, c4 = 4 * (lane & 15);
#pragma unroll
        for (int i = 0; i < 16; ++i) v[i] = __builtin_nontemporal_load((const f32x4*)(W + (size_t)(k0 + 4 * i + r4) * N + n0 + c4));
        float gv[16];
#pragma unroll
        for (int i = 0; i < 16; ++i) gv[i] = gain ? gain[k0 + 4 * i + r4] : 1.0f;
        __builtin_amdgcn_sched_barrier(0);
#pragma unroll
        for (int i = 0; i < 16; ++i) { const int kk = 4 * i + r4; const float g = gv[i];
            scr[kk * 65 + c4] = v[i][0] * g; scr[kk * 65 + c4 + 1] = v[i][1] * g; scr[kk * 65 + c4 + 2] = v[i][2] * g; scr[kk * 65 + c4 + 3] = v[i][3] * g; } }
    asm volatile("s_waitcnt lgkmcnt(0)" ::: "memory");
    int d0;
    if (mode == 0) d0 = row_off_or_S + n0;
    else { const int S = row_off_or_S; if (n0 < S) d0 = (n0 >> 7) * 256 + (n0 & 127); else { const int j = n0 - S; d0 = (j >> 7) * 256 + 128 + (j & 127); } }
    const int c = lane & 7;
#pragma unroll
    for (int j = 0; j < 8; ++j) { const int n = (lane >> 3) + 8 * j; const FLAS float* s = scr + (8 * c) * 65 + n;
        u32x4 o; o.x = pk2(s[0 * 65], s[1 * 65]); o.y = pk2(s[2 * 65], s[3 * 65]); o.z = pk2(s[4 * 65], s[5 * 65]); o.w = pk2(s[6 * 65], s[7 * 65]);
        st16_wt(WT, ((size_t)(d0 + n) * K + k0 + 8 * c) * 2, o); }
    asm volatile("s_waitcnt lgkmcnt(0)" ::: "memory");
}

__device__ __forceinline__ void phase_prep(Frame& F) {
    FLAS float* scr = (FLAS float*)(F.lds + F.wave * PREP_WAVE_LDS);
    const int gw = F.vcu * NWAVES + F.wave, NGW = F.G * NWAVES, lane = F.lane;
    for (int hw = NGW - 1 - gw; hw < 80; hw += NGW) {
        if (hw < 64) {
            const int g = hw, p = lane, pl = p & 31, ph = p >> 5;
            const float* gain = FIN(11);
            f32x4 br4[4], bi4[4], gn4[4]; float cr[16], ci[16];
#pragma unroll
            for (int q = 0; q < 4; ++q) { br4[q] = ((const f32x4*)(FIN(23) + (g * 64 + p) * 16))[q]; bi4[q] = ((const f32x4*)(FIN(24) + (g * 64 + p) * 16))[q]; gn4[q] = ((const f32x4*)(gain + g * 16))[q]; }
#pragma unroll
            for (int c = 0; c < 16; ++c) { cr[c] = FIN(25)[(g * 16 + c) * 64 + p]; ci[c] = FIN(26)[(g * 16 + c) * 64 + p]; }
            const float dtl = FIN(22)[g], lrf = FIN(20)[g * 64 + p], lif = FIN(21)[g * 64 + p];
            const float dvf = FIN(27)[g * 16 + (p & 15)] * gain[g * 16 + (p & 15)];
            __builtin_amdgcn_sched_barrier(0);
            const double dt = gold::d_exp((double)dtl);
            const double lr = (double)lrf, li = (double)lif;
            double sn, cs; gold::d_sincos(li * dt, sn, cs); const double er = gold::d_exp(lr * dt);
            const double lbr = er * cs, lbi = er * sn;
            double sn2, cs2; gold::d_sincos(li * dt * (double)S5L, sn2, cs2); const double er2 = gold::d_exp(lr * dt * (double)S5L);
            WSP(f32x2, WS_LAM)[g * 64 + p] = (f32x2){(float)lbr, (float)lbi};
            WSP(f32x2, WS_LAMP)[g * 64 + p] = (f32x2){(float)(er2 * cs2), (float)(er2 * sn2)};
            const double nr = lbr - 1.0, ni = lbi, den = lr * lr + li * li;
            const double fr = (nr * lr + ni * li) / den, fi = (ni * lr - nr * li) / den;
            bf16_t* BB = WSP(bf16_t, WS_BB); bf16_t* CP = WSP(bf16_t, WS_CP);
#pragma unroll
            for (int c = 0; c < 16; ++c) { const double br = br4[c >> 2][c & 3], bi = bi4[c >> 2][c & 3], gn = gn4[c >> 2][c & 3];
                BB[((g * 4 + ph) * 32 + pl) * 16 + c] = (bf16_t)f2bf((float)((fr * br - fi * bi) * gn));
                BB[((g * 4 + 2 + ph) * 32 + pl) * 16 + c] = (bf16_t)f2bf((float)((fr * bi + fi * br) * gn));
                CP[(g * 16 + c) * 160 + 4 * pl + 2 * ph] = (bf16_t)f2bf(cr[c]);
                CP[(g * 16 + c) * 160 + 4 * pl + 2 * ph + 1] = (bf16_t)f2bf(-ci[c]); }
            if (p < 16) {
                unsigned zz = 0u; asm volatile("" : "+v"(zz));
                const unsigned dval = f2bf(dvf);
                unsigned* cpw = (unsigned*)(CP + (g * 16 + p) * 160 + 128);
#pragma unroll
                for (int c2 = 0; c2 < 16; ++c2) cpw[c2] = (c2 < 8) ? (((2 * c2 == p) ? dval : zz) | ((2 * c2 + 1 == p) ? (dval << 16) : zz)) : zz;
            }
        } else { const int i = (hw - 64) * 64 + lane; WSP(float, WS_LB)[i] = 1.0f / (1.0f + expf(-(FIN(30)[1024 + i] - FIN(30)[i]))); }
    }
    constexpr int I_IN = 16 * 88, I_OUT = 44 * 16, I_SQ = 16 * 16, I_KV = 16 * 32, I_GLU = 16 * 32, I_HGIN = 16 * 64;
    constexpr int NITEMS = 4 * I_IN + 4 * I_OUT + 4 * I_SQ + 2 * I_KV + I_GLU + I_HGIN + I_SQ;
    for (int it = gw; it < NITEMS; it += NGW) {
        int r = it;
        if (r < 4 * I_IN) { const int w = r / I_IN, l = w & 1, second = w >> 1; r -= w * I_IN;
            prep_transpose_item(FIN(second ? 18 : 9) + (size_t)l * D * 2 * FF, D, 2 * FF, WSP(bf16_t, (second ? WS_W2IN : WS_W1IN) + l * W1IN_SZ), 1, FF, FIN(second ? 17 : 8) + l * D, scr, r, lane); continue; }
        r -= 4 * I_IN;
        if (r < 4 * I_OUT) { const int w = r / I_OUT, l = w & 1, second = w >> 1; r -= w * I_OUT;
            prep_transpose_item(FIN(second ? 19 : 10) + (size_t)l * FF * D, FF, D, WSP(bf16_t, (second ? WS_W2OUT : WS_W1OUT) + l * W1OUT_SZ), 0, 0, nullptr, scr, r, lane); continue; }
        r -= 4 * I_OUT;
        if (r < 2 * I_SQ) { const int l = r / I_SQ; r -= l * I_SQ;
            prep_transpose_item(FIN(14) + (size_t)l * D * D, D, D, WSP(bf16_t, WS_WQ + l * WQ_SZ), 0, 0, FIN(12) + l * D, scr, r, lane); continue; }
        r -= 2 * I_SQ;
        if (r < 2 * I_SQ) { const int l = r / I_SQ; r -= l * I_SQ;
            prep_transpose_item(FIN(16) + (size_t)l * D * D, D, D, WSP(bf16_t, WS_WO + l * WQ_SZ), 0, 0, nullptr, scr, r, lane); continue; }
        r -= 2 * I_SQ;
        if (r < 2 * I_KV) { const int l = r / I_KV; r -= l * I_KV;
            prep_transpose_item(FIN(15) + (size_t)l * D * 2 * D, D, 2 * D, WSP(bf16_t, WS_WKV), 0, l * 2048, FIN(13) + l * D, scr, r, lane); continue; }
        r -= 2 * I_KV;
        if (r < I_GLU) { prep_transpose_item(FIN(28), D, 2 * D, WSP(bf16_t, WS_WGLU), 1, D, nullptr, scr, r, lane); continue; }
        r -= I_GLU;
        if (r < I_HGIN) { prep_transpose_item(FIN(29), D, 4 * D, WSP(bf16_t, WS_WHGIN), 0, 0, FIN(11) + D, scr, r, lane); continue; }
        r -= I_HGIN;
        prep_transpose_item(FIN(32), D, D, WSP(bf16_t, WS_WHGOUT), 0, 0, nullptr, scr, r, lane);
    }
    bf16_t* XB = WSP(bf16_t, WS_XB); float* SSQ = WSP(float, WS_SSQ);
    for (int row = gw; row < MT; row += 2 * NGW) {
        const int row2 = row + NGW; const bool has2 = row2 < MT;
        f32x4 v[8];
        const float* src = row < MP ? FIN(0) + (size_t)row * D : FIN(1) + (size_t)(row - MP) * D;
        const float* src2 = row2 < MP ? FIN(0) + (size_t)row2 * D : FIN(1) + (size_t)(row2 - MP) * D;
#pragma unroll
        for (int j = 0; j < 4; ++j) v[j] = row < R ? __builtin_nontemporal_load((const f32x4*)src + lane + 64 * j) : (f32x4){0.f, 0.f, 0.f, 0.f};
#pragma unroll
        for (int j = 0; j < 4; ++j) v[4 + j] = (has2 && row2 < R) ? __builtin_nontemporal_load((const f32x4*)src2 + lane + 64 * j) : (f32x4){0.f, 0.f, 0.f, 0.f};
        __builtin_amdgcn_sched_barrier(0);
#pragma unroll
        for (int h = 0; h < 2; ++h) {
            const int rw = h ? row2 : row;
            if (h == 0 || has2) {
                float s = 0.f;
#pragma unroll
                for (int j = 0; j < 4; ++j) { const f32x4 w4 = v[4 * h + j]; s += (w4[0] * w4[0] + w4[1] * w4[1]) + (w4[2] * w4[2] + w4[3] * w4[3]); }
                s = wave_sum(s);
#pragma unroll
                for (int j = 0; j < 4; ++j) { const f32x4 w4 = v[4 * h + j]; u32x2 w; w.x = pk2(w4[0], w4[1]); w.y = pk2(w4[2], w4[3]); ((u32x2*)(XB + (size_t)rw * D))[lane + 64 * j] = w; }
                if (lane < 32) SSQ[(size_t)rw * 32 + lane] = lane == 0 ? s : 0.f;
                if (rw >= MP && rw < R) WSP(float, WS_SSQS)[(size_t)(rw - MP) * 64 + lane] = lane == 0 ? s : 0.f;
            }
        }
    }
    bf16_t* MEMN = WSP(bf16_t, WS_MEMN);
    for (int row = gw; row < NB * NMEM; row += NGW) {
        f32x4 v[4]; float s = 0.f;
#pragma unroll
        for (int j = 0; j < 4; ++j) { v[j] = __builtin_nontemporal_load((const f32x4*)(FIN(2) + (size_t)row * D) + lane + 64 * j); s += (v[j][0] * v[j][0] + v[j][1] * v[j][1]) + (v[j][2] * v[j][2] + v[j][3] * v[j][3]); }
        const float rs = 1.0f / sqrtf(wave_sum(s) * (1.0f / D) + EPS);
#pragma unroll
        for (int j = 0; j < 4; ++j) { u32x2 w; w.x = pk2(v[j][0] * rs, v[j][1] * rs); w.y = pk2(v[j][2] * rs, v[j][3] * rs); ((u32x2*)(MEMN + (size_t)row * D))[lane + 64 * j] = w; }
    }
}

constexpr int S5_RS = 336;
template <int MODE> __device__ __forceinline__ void s5_task(Frame& F, int gb, int sp) {
    const int lane = F.lane, g = gb * 8 + F.wave, col = lane & 31, hi = lane >> 5;
    const bf16_t* XBp = WSP(bf16_t, WS_XB); const float* SSQ = WSP(float, WS_SSQ);
    const bf16_t* BB = WSP(bf16_t, WS_BB); const bf16_t* CP = WSP(bf16_t, WS_CP);
    FLAS unsigned char* hl = F.lds + F.wave * (32 * S5_RS + 1024);
    bf16x8 bbf[4];
#pragma unroll
    for (int nb = 0; nb < 4; ++nb) bbf[nb] = *(const bf16x8*)(BB + ((g * 4 + nb) * 32 + col) * 16 + 8 * hi);
    const f32x2 lam0 = WSP(f32x2, WS_LAM)[g * 64 + col], lam1 = WSP(f32x2, WS_LAM)[g * 64 + 32 + col];
    const int rho = lane & 31, hr = (rho >> 2) & 1, tr = (rho & 3) + 4 * (rho >> 3);
    int rowA, rowC0, rowC1;
    int nsteps;
    if (MODE == 2) { rowC0 = MP + sp * 32; rowC1 = rowC0 + 16; nsteps = 1; }
    else { const int s0 = sp, s1 = sp + 64; rowC0 = (s0 >> 4) * T + (s0 & 15) * S5L; rowC1 = (s1 >> 4) * T + (s1 & 15) * S5L; nsteps = S5L / 16; }
    rowA = hr ? rowC1 : rowC0;
    float h0r = 0.f, h0i = 0.f, h1r = 0.f, h1i = 0.f;
    if (MODE == 1) {
        const int s = sp + 64 * hi, c = s & 15;
        const f32x2 lp0 = WSP(f32x2, WS_LAMP)[g * 64 + col], lp1 = WSP(f32x2, WS_LAMP)[g * 64 + 32 + col];
        const f32x2* E = WSP(f32x2, WS_E);
        f32x2 e0[S5NC - 1], e1[S5NC - 1];
#pragma unroll
        for (int mch = 0; mch < S5NC - 1; ++mch) { const int mm = mch < c ? mch : 0;
            e0[mch] = E[((size_t)(s - c + mm) * 64 + g) * 64 + col]; e1[mch] = E[((size_t)(s - c + mm) * 64 + g) * 64 + 32 + col]; }
        __builtin_amdgcn_sched_barrier(0);
#pragma unroll
        for (int mch = 0; mch < S5NC - 1; ++mch) if (mch < c) {
            const float a = lp0[0] * h0r - lp0[1] * h0i + e0[mch][0], b = lp0[0] * h0i + lp0[1] * h0r + e0[mch][1]; h0r = a; h0i = b;
            const float a1 = lp1[0] * h1r - lp1[1] * h1i + e1[mch][0], b1 = lp1[0] * h1i + lp1[1] * h1r + e1[mch][1]; h1r = a1; h1i = b1;
        }
    }
    bf16x8 cpf[5];
    if (MODE != 0) {
#pragma unroll
        for (int ks = 0; ks < 5; ++ks) cpf[ks] = *(const bf16x8*)(CP + (g * 16 + (lane & 15)) * 160 + 32 * ks + 8 * (lane >> 4));
    }
    u32x4 un_; f32x4 spn_[4];
    if (MODE != 2) { const int ar0 = rowA + tr; un_ = *(const u32x4*)(XBp + (size_t)ar0 * D + g * 16 + 8 * hi);
#pragma unroll
        for (int i = 0; i < 4; ++i) spn_[i] = *(const f32x4*)(SSQ + (size_t)ar0 * 32 + 4 * i); }
    for (int step = 0; step < nsteps; ++step) {
        const int arow = rowA + step * 16 + tr;
        float rs; f32x4 u0, u1;
        if (MODE == 2) { rs = srow_rstd(WSP(float, WS_SSQS), arow - MP); bf8_to_f32(*(const u32x4*)(XBp + (size_t)arow * D + g * 16 + 8 * hi), u0, u1); }
        else {
            float a_ = 0.f;
#pragma unroll
            for (int i = 0; i < 4; ++i) a_ += (spn_[i][0] + spn_[i][1]) + (spn_[i][2] + spn_[i][3]);
            rs = 1.0f / sqrtf(a_ * (1.0f / D) + EPS); bf8_to_f32(un_, u0, u1);
            const int arn = rowA + (step + 1 < nsteps ? step + 1 : step) * 16 + tr;
            un_ = *(const u32x4*)(XBp + (size_t)arn * D + g * 16 + 8 * hi);
#pragma unroll
            for (int i = 0; i < 4; ++i) spn_[i] = *(const f32x4*)(SSQ + (size_t)arn * 32 + 4 * i);
            __builtin_amdgcn_sched_barrier(0);
        }
        u32x4 aw; aw.x = pk2(u0[0] * rs, u0[1] * rs); aw.y = pk2(u0[2] * rs, u0[3] * rs); aw.z = pk2(u1[0] * rs, u1[1] * rs); aw.w = pk2(u1[2] * rs, u1[3] * rs);
        const bf16x8 af = __builtin_bit_cast(bf16x8, aw);
        f32x16 bu[4];
#pragma unroll
        for (int nb = 0; nb < 4; ++nb) { f32x16 z = {}; bu[nb] = __builtin_amdgcn_mfma_f32_32x32x16_bf16(af, bbf[nb], z, 0, 0, 0); }
        if (MODE != 0) { asm volatile("s_waitcnt lgkmcnt(0)" ::: "memory");
            *(FLAS u32x4*)(hl + (16 * hr + tr) * S5_RS + 256 + 16 * hi) = aw; }
        const int crow0 = hi ? rowC1 : rowC0;
        float s0rv[16], s0iv[16], s1rv[16], s1iv[16];
        if (MODE == 2) {
#pragma unroll
            for (int r = 0; r < 16; ++r) { const size_t o_ = ((size_t)((crow0 - MP) + r) * 64 + g) * 64 + col;
                s0rv[r] = FIN(3)[o_]; s0iv[r] = FIN(4)[o_]; s1rv[r] = FIN(3)[o_ + 32]; s1iv[r] = FIN(4)[o_ + 32]; }
            __builtin_amdgcn_sched_barrier(0);
        }
#pragma unroll
        for (int r = 0; r < 16; ++r) {
            if (MODE == 2) {
                const int smp = (crow0 - MP) + r;
                const float s0r = s0rv[r], s0i = s0iv[r], s1r = s1rv[r], s1i = s1iv[r];
                h0r = lam0[0] * s0r - lam0[1] * s0i + bu[0][r]; h0i = lam0[0] * s0i + lam0[1] * s0r + bu[2][r];
                h1r = lam1[0] * s1r - lam1[1] * s1i + bu[1][r]; h1i = lam1[0] * s1i + lam1[1] * s1r + bu[3][r];
                F.out[O_S5RE_S + ((size_t)smp * 64 + g) * 64 + col] = h0r; F.out[O_S5IM_S + ((size_t)smp * 64 + g) * 64 + col] = h0i;
                F.out[O_S5RE_S + ((size_t)smp * 64 + g) * 64 + 32 + col] = h1r; F.out[O_S5IM_S + ((size_t)smp * 64 + g) * 64 + 32 + col] = h1i;
            } else {
                const float a = lam0[0] * h0r - lam0[1] * h0i + bu[0][r], b = lam0[0] * h0i + lam0[1] * h0r + bu[2][r]; h0r = a; h0i = b;
                const float a1 = lam1[0] * h1r - lam1[1] * h1i + bu[1][r], b1 = lam1[0] * h1i + lam1[1] * h1r + bu[3][r]; h1r = a1; h1i = b1;
            }
            if (MODE != 0) { u32x2 w; w.x = pk2(h0r, h0i); w.y = pk2(h1r, h1i); *(FLAS u32x2*)(hl + (16 * hi + r) * S5_RS + 8 * col) = w; }
        }
        if (MODE != 0) {
            asm volatile("s_waitcnt lgkmcnt(0)" ::: "memory");
#pragma unroll
            for (int tile = 0; tile < 2; ++tile) {
                f32x4 y = {0.f, 0.f, 0.f, 0.f};
                bf16x8 ya[5];
#pragma unroll
                for (int ks = 0; ks < 5; ++ks) ya[ks] = *(const FLAS bf16x8*)(hl + (16 * tile + (lane & 15)) * S5_RS + 64 * ks + 16 * (lane >> 4));
                __builtin_amdgcn_sched_barrier(0);
                if ((lane >> 4) >= 2) ya[4] = (bf16x8){0, 0, 0, 0, 0, 0, 0, 0};
#pragma unroll
                for (int ks = 0; ks < 5; ++ks) y = __builtin_amdgcn_mfma_f32_16x16x32_bf16(ya[ks], cpf[ks], y, 0, 0, 0);
                FLAS bf16_t* ys = (FLAS bf16_t*)(hl + 32 * S5_RS);
#pragma unroll
                for (int j = 0; j < 4; ++j) { const float v = y[j]; const float z = 0.7978845608028654f * (v + 0.044715f * v * v * v);
                    const float ge = v * fast_rcp(1.0f + fast_exp(-2.0f * z));
                    ys[(16 * tile + 4 * (lane >> 4) + j) * 16 + (lane & 15)] = (bf16_t)f2bf(ge); }
            }
            asm volatile("s_waitcnt lgkmcnt(0)" ::: "memory");
            {   const int yr = lane >> 1, yh = lane & 1;
                const u32x4 yv = *(const FLAS u32x4*)(hl + 32 * S5_RS + yr * 32 + 16 * yh);
                *(u32x4*)(WSP(bf16_t, WS_AB) + (size_t)(((yr >> 4) ? rowC1 : rowC0) + step * 16 + (yr & 15)) * D + g * 16 + 8 * yh) = yv; }
        }
    }
    if (MODE == 0) {
        f32x2* E = WSP(f32x2, WS_E); const int s = sp + 64 * hi;
        E[((size_t)s * 64 + g) * 64 + col] = (f32x2){h0r, h0i}; E[((size_t)s * 64 + g) * 64 + 32 + col] = (f32x2){h1r, h1i};
    }
    if (MODE == 1) {
        const int s = sp + 64 * hi;
        if ((s & 15) == 15) { const int b = s >> 4;
            F.out[O_S5RE_P + ((size_t)b * 64 + g) * 64 + col] = h0r; F.out[O_S5IM_P + ((size_t)b * 64 + g) * 64 + col] = h0i;
            F.out[O_S5RE_P + ((size_t)b * 64 + g) * 64 + 32 + col] = h1r; F.out[O_S5IM_P + ((size_t)b * 64 + g) * 64 + 32 + col] = h1i; }
    }
}
template <int MODE> __device__ __forceinline__ void phase_s5(Frame& F) {
    for (int t = F.vcu; t < 512; t += F.G) s5_task<MODE>(F, t & 7, t >> 3);
    if (MODE == 1) { for (int t = F.vcu; t < 32; t += F.G) s5_task<2>(F, t & 7, t >> 3); }
    asm volatile("s_waitcnt lgkmcnt(0)" ::: "memory");
}
__device__ __forceinline__ int crow(int r, int hi) { return (r & 3) + 8 * (r >> 2) + 4 * hi; }
template <int PITCH> __device__ __forceinline__ void attn_stage_tile(Frame& F, const bf16_t* __restrict__ src  ) {
    const int r0 = F.tid >> 5, ch = F.tid & 31;
    const bf16_t* g0 = src + (size_t)r0 * PITCH + 8 * ch;
    FLAS unsigned char* l0 = F.lds + r0 * 512 + ((ch ^ (r0 & 15)) << 4);
    u32x4 v[16];
#pragma unroll
    for (int i = 0; i < 16; ++i) v[i] = *(const u32x4*)(g0 + (size_t)(16 * i) * PITCH);
    __builtin_amdgcn_sched_barrier(0);
#pragma unroll
    for (int i = 0; i < 16; ++i) *(FLAS u32x4*)(l0 + i * 8192) = v[i];
    __builtin_amdgcn_sched_barrier(0);
}
__device__ __forceinline__ bf16x8 attn_frag(const FLAS unsigned char* lds, int row, int ch) { return *(const FLAS bf16x8*)(lds + row * 512 + ((ch ^ (row & 15)) << 4)); }
__device__ __forceinline__ void attn_prompt_unit(Frame& F, int layer, int unit) {
    const int lane = F.lane, ql = lane & 31, hh = lane >> 5;
    const int b = unit >> 5, h = (unit >> 3) & 3, qb = unit & 7;
    const bf16_t* QB = WSP(bf16_t, WS_QB); const bf16_t* KB = WSP(bf16_t, WS_KBM) + (size_t)layer * 2048 * D; const bf16_t* VT = WSP(bf16_t, WS_VTM) + (size_t)layer * 8 * 4 * 256 * 256;
    bf16_t* AB = WSP(bf16_t, WS_AB);
    const int row = b * T + qb * 256 + F.wave * 32 + ql;
    const bf16_t* qp = QB + (size_t)row * D + h * 256 + 8 * hh;
    attn_stage_tile<D>(F, KB + ((size_t)b * 256) * D + h * 256);
    asm volatile("s_waitcnt vmcnt(0) lgkmcnt(0)" ::: "memory"); __builtin_amdgcn_s_barrier(); asm volatile("" ::: "memory");
    f32x16 s[8];
#pragma unroll
    for (int kb = 0; kb < 8; ++kb) s[kb] = (f32x16){};
    bf16x8 qf = *(const bf16x8*)qp;
#pragma unroll
    for (int ks = 0; ks < 16; ++ks) {
        bf16x8 kf[8]; const bf16x8 qn = *(const bf16x8*)(qp + 16 * (ks < 15 ? ks + 1 : ks));
#pragma unroll
        for (int kb = 0; kb < 8; ++kb) kf[kb] = attn_frag(F.lds, 32 * kb + ql, 2 * ks + hh);
        __builtin_amdgcn_sched_barrier(0);
#pragma unroll
        for (int kb = 0; kb < 8; ++kb) s[kb] = __builtin_amdgcn_mfma_f32_32x32x16_bf16(kf[kb], qf, s[kb], 0, 0, 0);
        __builtin_amdgcn_sched_barrier(0);
        qf = qn;
    }
    asm volatile("s_waitcnt lgkmcnt(0)" ::: "memory"); __builtin_amdgcn_s_barrier(); asm volatile("" ::: "memory");
    float mx = -3.0e38f;
#pragma unroll
    for (int kb = 0; kb < 8; ++kb)
#pragma unroll
        for (int r = 0; r < 16; ++r) mx = fmaxf(mx, s[kb][r]);
    mx = fmaxf(mx, __shfl_xor(mx, 32));
    float l = 0.f;
    bf16x8 pf[8][2];
#pragma unroll
    for (int kb = 0; kb < 8; ++kb) {
        float p[16];
#pragma unroll
        for (int r = 0; r < 16; ++r) { p[r] = __builtin_amdgcn_exp2f(s[kb][r] - mx); l += p[r]; }
#pragma unroll
        for (int s2 = 0; s2 < 2; ++s2) { u32x4 w; w.x = pk2(p[8 * s2 + 0], p[8 * s2 + 1]); w.y = pk2(p[8 * s2 + 2], p[8 * s2 + 3]); w.z = pk2(p[8 * s2 + 4], p[8 * s2 + 5]); w.w = pk2(p[8 * s2 + 6], p[8 * s2 + 7]);
            pf[kb][s2] = __builtin_bit_cast(bf16x8, w); }
    }
    l += __shfl_xor(l, 32);
    const float inv = 1.0f / l;
    attn_stage_tile<256>(F, VT + (((size_t)b * 4 + h) * 256) * 256);
    asm volatile("s_waitcnt vmcnt(0) lgkmcnt(0)" ::: "memory"); __builtin_amdgcn_s_barrier(); asm volatile("" ::: "memory");
#pragma unroll 1
    for (int half = 0; half < 2; ++half) {
        f32x16 o[4];
#pragma unroll
        for (int i = 0; i < 4; ++i) o[i] = (f32x16){};
#pragma unroll
        for (int st = 0; st < 16; st += 2) {
            bf16x8 vf[8];
#pragma unroll
            for (int j = 0; j < 8; ++j) vf[j] = attn_frag(F.lds, 32 * (4 * half + (j & 3)) + ql, 2 * (st + (j >> 2)) + hh);
            __builtin_amdgcn_sched_barrier(0);
#pragma unroll
            for (int j = 0; j < 8; ++j) o[j & 3] = __builtin_amdgcn_mfma_f32_32x32x16_bf16(vf[j], pf[(st + (j >> 2)) >> 1][(st + (j >> 2)) & 1], o[j & 3], 0, 0, 0);
            __builtin_amdgcn_sched_barrier(0);
        }
#pragma unroll
        for (int i = 0; i < 4; ++i)
#pragma unroll
            for (int r4 = 0; r4 < 4; ++r4) { u32x2 w; w.x = pk2(o[i][4 * r4] * inv, o[i][4 * r4 + 1] * inv); w.y = pk2(o[i][4 * r4 + 2] * inv, o[i][4 * r4 + 3] * inv);
                *(u32x2*)(AB + (size_t)row * D + h * 256 + 32 * (4 * half + i) + 8 * r4 + 4 * hh) = w; }
    }
    asm volatile("s_waitcnt lgkmcnt(0)" ::: "memory"); __builtin_amdgcn_s_barrier(); asm volatile("" ::: "memory");
}
#define TR_LEVEL(N_, SH_) _Pragma("unroll") for (int i = 0; i < (N_); ++i) { const bool up = (lane & (SH_)) != 0; const float keep = up ? v[2 * i + 1] : v[2 * i], send = up ? v[2 * i] : v[2 * i + 1]; v[i] = keep + __shfl_xor(send, (SH_)); }
__device__ __forceinline__ float transpose_reduce64(float (&v)[64], int lane) {
    TR_LEVEL(32, 1) TR_LEVEL(16, 2) TR_LEVEL(8, 4) TR_LEVEL(4, 8) TR_LEVEL(2, 16) TR_LEVEL(1, 32)
    return v[0];
}
__device__ __forceinline__ void attn_sample_unit(Frame& F, int layer, int unit) {
    const int lane = F.lane, w = F.wave, b = unit >> 1, hp = unit & 1, hl = w >> 2, head = 2 * hp + hl, kq = w & 3;
    FLAS float* sc = (FLAS float*)F.lds;
    FLAS float* op = (FLAS float*)(F.lds + 2048);
    FLAS float* ls = (FLAS float*)(F.lds + 2048 + 8192);
    const bf16_t* QB = WSP(bf16_t, WS_QB); bf16_t* AB = WSP(bf16_t, WS_AB);
    const float* Kc = FIN(6) + (((size_t)layer * MS + b) * NMEM + 64 * kq) * D + head * 256 + 4 * lane;
    const float* Vc = FIN(7) + (((size_t)layer * MS + b) * NMEM + 64 * kq) * D + head * 256 + 4 * lane;
    const u32x2 qw = *(const u32x2*)(QB + (size_t)(MP + b) * D + head * 256 + 4 * lane);
    const float q0 = bflo(qw.x), q1 = bfhi(qw.x), q2 = bflo(qw.y), q3 = bfhi(qw.y);
    float v[64];
    {
        f32x4 kb[3][8];
#pragma unroll
        for (int s = 0; s < 3; ++s)
#pragma unroll
            for (int i = 0; i < 8; ++i) kb[s][i] = __builtin_nontemporal_load((const f32x4*)(Kc + (size_t)(8 * s + i) * D));
#pragma unroll
        for (int bt = 0; bt < 8; ++bt) {
            __builtin_amdgcn_sched_barrier(0);
#pragma unroll
            for (int i = 0; i < 8; ++i) v[8 * bt + i] = (q0 * kb[bt % 3][i][0] + q1 * kb[bt % 3][i][1]) + (q2 * kb[bt % 3][i][2] + q3 * kb[bt % 3][i][3]);
            __builtin_amdgcn_sched_barrier(0);
            if (bt + 3 < 8) {
#pragma unroll
                for (int i = 0; i < 8; ++i) kb[bt % 3][i] = __builtin_nontemporal_load((const f32x4*)(Kc + (size_t)(8 * (bt + 3) + i) * D)); }
        }
        __builtin_amdgcn_sched_barrier(0);
    }
    f32x4 vb[3][8];
#pragma unroll
    for (int i = 0; i < 8; ++i) vb[0][i] = __builtin_nontemporal_load((const f32x4*)(Vc + (size_t)i * D));
#pragma unroll
    for (int i = 0; i < 8; ++i) vb[1][i] = __builtin_nontemporal_load((const f32x4*)(Vc + (size_t)(8 + i) * D));
    __builtin_amdgcn_sched_barrier(0);
    const float sv = transpose_reduce64(v, lane);
    sc[hl * 256 + 64 * kq + lane] = sv;
    asm volatile("s_waitcnt lgkmcnt(0)" ::: "memory"); __builtin_amdgcn_s_barrier(); asm volatile("" ::: "memory");
    float mx = fmaxf(fmaxf(sc[hl * 256 + lane], sc[hl * 256 + 64 + lane]), fmaxf(sc[hl * 256 + 128 + lane], sc[hl * 256 + 192 + lane]));
#pragma unroll
    for (int o = 1; o < 64; o <<= 1) mx = fmaxf(mx, __shfl_xor(mx, o));
    const float pv = __builtin_amdgcn_exp2f(sv - mx);
    const float lpart = wave_sum(pv);
    f32x4 o = {0.f, 0.f, 0.f, 0.f};
    {
#pragma unroll
        for (int i = 0; i < 8; ++i) vb[2][i] = __builtin_nontemporal_load((const f32x4*)(Vc + (size_t)(16 + i) * D));
#pragma unroll
        for (int bt = 0; bt < 8; ++bt) {
            __builtin_amdgcn_sched_barrier(0);
#pragma unroll
            for (int i = 0; i < 8; ++i) { const float p = __builtin_bit_cast(float, __builtin_amdgcn_readlane(__builtin_bit_cast(int, pv), 8 * bt + i)); o = o + vb[bt % 3][i] * p; }
            __builtin_amdgcn_sched_barrier(0);
            if (bt + 3 < 8) {
#pragma unroll
                for (int i = 0; i < 8; ++i) vb[bt % 3][i] = __builtin_nontemporal_load((const f32x4*)(Vc + (size_t)(8 * (bt + 3) + i) * D)); }
        }
        __builtin_amdgcn_sched_barrier(0);
    }
    *(FLAS f32x4*)(op + (hl * 4 + kq) * 256 + 4 * lane) = o;
    if (lane == 0) ls[hl * 4 + kq] = lpart;
    asm volatile("s_waitcnt lgkmcnt(0)" ::: "memory"); __builtin_amdgcn_s_barrier(); asm volatile("" ::: "memory");
    if (kq == 0) {
        const float inv = 1.0f / ((ls[hl * 4] + ls[hl * 4 + 1]) + (ls[hl * 4 + 2] + ls[hl * 4 + 3]));
        f32x4 t = *(const FLAS f32x4*)(op + (hl * 4) * 256 + 4 * lane);
#pragma unroll
        for (int j = 1; j < 4; ++j) t = t + *(const FLAS f32x4*)(op + (hl * 4 + j) * 256 + 4 * lane);
        u32x2 wv; wv.x = pk2(t[0] * inv, t[1] * inv); wv.y = pk2(t[2] * inv, t[3] * inv);
        *(u32x2*)(AB + (size_t)(MP + b) * D + head * 256 + 4 * lane) = wv;
    }
    asm volatile("s_waitcnt lgkmcnt(0)" ::: "memory"); __builtin_amdgcn_s_barrier(); asm volatile("" ::: "memory");
}
__device__ __forceinline__ void phase_attn(Frame& F, int layer) {
#if defined(ATREP)
    for (int r_ = 0; r_ < (((ATREP) & 1) ? 2 : 0); ++r_) { asm volatile("" ::: "memory"); for (int u = F.vcu; u < 256; u += F.G) attn_prompt_unit(F, layer, u); }
    for (int r_ = 0; r_ < (((ATREP) & 2) ? 2 : 0); ++r_) { asm volatile("" ::: "memory"); for (int u = F.vcu; u < 256; u += F.G) attn_sample_unit(F, layer, u); }
#endif
    if (F.vcu & 1) {
        for (int u = F.vcu; u < 256; u += F.G) attn_sample_unit(F, layer, u);
        for (int u = F.vcu; u < 256; u += F.G) attn_prompt_unit(F, layer, u);
    } else {
        for (int u = F.vcu; u < 256; u += F.G) attn_prompt_unit(F, layer, u);
        for (int u = F.vcu; u < 256; u += F.G) attn_sample_unit(F, layer, u);
    }
}

constexpr int VRS = 320;
__device__ __forceinline__ void stage_v_tile(Frame& F, FLAS unsigned char* vt, int row0, int h) {
    const bf16_t* VN = WSP(bf16_t, WS_VT);
#pragma unroll
    for (int i = 0; i < 2; ++i) { const int r = 8 * F.wave + 4 * i + (F.lane >> 4), ch = F.lane & 15;
        const u32x4 v = *(const u32x4*)(VN + (size_t)(row0 + r) * D + h * 128 + 8 * ch); *(FLAS u32x4*)(vt + r * VRS + 16 * ch) = v; }
}
typedef short v4i16_t __attribute__((ext_vector_type(4)));
__device__ __forceinline__ bf16x8 vt_frag(const FLAS unsigned char* vt, int vb, int ts, int lane) {
    const int hh = lane >> 5, q = (lane & 15) >> 2, p = lane & 3, cb = 32 * vb + 16 * ((lane >> 4) & 1);
    const FLAS unsigned char* a0 = vt + (16 * ts + 4 * hh + q) * VRS + 2 * (cb + 4 * p);
    const v4i16_t lo = __builtin_amdgcn_ds_read_tr16_b64_v4i16((FLAS v4i16_t*)a0);
    const v4i16_t hi = __builtin_amdgcn_ds_read_tr16_b64_v4i16((FLAS v4i16_t*)(a0 + 8 * VRS));
    return (bf16x8){lo[0], lo[1], lo[2], lo[3], hi[0], hi[1], hi[2], hi[3]};
}
__device__ __forceinline__ void hga_unit(Frame& F, int unit) {
    const int lane = F.lane, w = F.wave, kb = w & 3, vh = w >> 2, kc = lane & 31, hh = lane >> 5;
    const int bh = unit >> 5, n = unit & 31, b = bh >> 3, h = bh & 7;
    FLAS unsigned char* vt = F.lds;
    const float* LOGF = WSP(float, WS_LOGF) + ((size_t)b * T + n * 64) * D + h * 128 + 32 * kb + kc;
    float kd[64]; float suf = 0.f;
#pragma unroll
    for (int t = 0; t < 64; ++t) kd[t] = LOGF[(size_t)t * D];
    __builtin_amdgcn_sched_barrier(0);
    stage_v_tile(F, vt, b * T + n * 64, h);
    __builtin_amdgcn_sched_barrier(0);
#pragma unroll
    for (int t = 63; t >= 0; --t) { const float lf = kd[t]; kd[t] = (1.0f - fast_exp(lf)) * fast_exp(suf); suf += lf; }
    bf16x8 kf[4];
#pragma unroll
    for (int ts = 0; ts < 4; ++ts) { float e[8];
#pragma unroll
        for (int j = 0; j < 8; ++j) { const int tlo = 16 * ts + 8 * (j >> 2) + (j & 3); e[j] = hh ? kd[tlo + 4] : kd[tlo]; }
        u32x4 wv; wv.x = pk2(e[0], e[1]); wv.y = pk2(e[2], e[3]); wv.z = pk2(e[4], e[5]); wv.w = pk2(e[6], e[7]); kf[ts] = __builtin_bit_cast(bf16x8, wv); }
    asm volatile("s_waitcnt vmcnt(0) lgkmcnt(0)" ::: "memory"); __builtin_amdgcn_s_barrier(); asm volatile("" ::: "memory");
    bf16_t* SL = WSP(bf16_t, WS_SLOC) + (size_t)unit * 16384;
#pragma unroll
    for (int vi = 0; vi < 2; ++vi) { const int vb = 2 * vh + vi; f32x16 acc = {};
#pragma unroll
        for (int ts = 0; ts < 4; ++ts) { const bf16x8 vf = vt_frag(vt, vb, ts, lane); acc = __builtin_amdgcn_mfma_f32_32x32x16_bf16(vf, kf[ts], acc, 0, 0, 0); }
#pragma unroll
        for (int r = 0; r < 16; ++r) SL[(size_t)(32 * vb + crow(r, hh)) * 128 + 32 * kb + kc] = (bf16_t)f2bf(acc[r]); }
    if (vh == 0 && hh == 0) WSP(float, WS_BT)[(size_t)unit * 128 + 32 * kb + kc] = suf;
    asm volatile("s_waitcnt lgkmcnt(0)" ::: "memory"); __builtin_amdgcn_s_barrier(); asm volatile("" ::: "memory");
}
__device__ __forceinline__ void phase_hgb(Frame& F) {
    const bf16_t* SL = WSP(bf16_t, WS_SLOC); const float* BT = WSP(float, WS_BT); bf16_t* SST = WSP(bf16_t, WS_SST);
    for (int chain = F.vcu * NTHR + F.tid; chain < 64 * 128 * 32; chain += F.G * NTHR) {
        const int bh = chain >> 12, v = (chain >> 5) & 127, k4 = chain & 31;
        f32x4 S = {0.f, 0.f, 0.f, 0.f};
        for (int n0 = 0; n0 < 32; n0 += 16) {
            u32x2 lw[16]; f32x4 bt[16];
#pragma unroll
            for (int j = 0; j < 16; ++j) { const size_t u = (size_t)bh * 32 + n0 + j; lw[j] = *(const u32x2*)(SL + u * 16384 + v * 128 + 4 * k4); bt[j] = *(const f32x4*)(BT + u * 128 + 4 * k4); }
            __builtin_amdgcn_sched_barrier(0);
#pragma unroll
            for (int j = 0; j < 16; ++j) { const size_t u = (size_t)bh * 32 + n0 + j;
                u32x2 wv; wv.x = pk2(S[0], S[1]); wv.y = pk2(S[2], S[3]); *(u32x2*)(SST + u * 16384 + v * 128 + 4 * k4) = wv;
                const f32x4 loc = {bflo(lw[j].x), bfhi(lw[j].x), bflo(lw[j].y), bfhi(lw[j].y)};
#pragma unroll
                for (int i = 0; i < 4; ++i) S[i] = fast_exp(bt[j][i]) * S[i] + loc[i]; }
            __builtin_amdgcn_sched_barrier(0);
        }
#pragma unroll
        for (int i = 0; i < 4; ++i) F.out[O_HG_P + ((size_t)bh * 128 + 4 * k4 + i) * 128 + v] = S[i];
    }
}
constexpr int HC_RS = 272;
struct HgcPre { f32x4 lf[4]; u32x4 q[2]; u32x4 v[2]; bf16x8 sa[8]; u32x2 g[4]; f32x4 gn[4]; };
__device__ __forceinline__ void hgc_prefetch(Frame& F, int unit, HgcPre& P) {
    const int lane = F.lane, w = F.wave;
    const int bh = unit >> 5, n = unit & 31, b = bh >> 3, h = bh & 7, row0 = b * T + n * 64;
    const size_t off = (size_t)(row0 + lane) * D + h * 128 + 16 * w;
#pragma unroll
    for (int i = 0; i < 4; ++i) P.lf[i] = *(const f32x4*)(WSP(float, WS_LOGF) + off + 4 * i);
    P.q[0] = *(const u32x4*)(WSP(bf16_t, WS_QB) + off); P.q[1] = *(const u32x4*)(WSP(bf16_t, WS_QB) + off + 8);
#pragma unroll
    for (int i = 0; i < 2; ++i) { const int r = 8 * w + 4 * i + (lane >> 4), ch = lane & 15; P.v[i] = *(const u32x4*)(WSP(bf16_t, WS_VT) + (size_t)(row0 + r) * D + h * 128 + 8 * ch); }
    const int tb = w & 1, vb = w >> 1, tl = lane & 31, hh = lane >> 5;
    const bf16_t* SST = WSP(bf16_t, WS_SST) + (size_t)unit * 16384 + (size_t)(32 * vb + tl) * 128 + 8 * hh;
#pragma unroll
    for (int ks = 0; ks < 8; ++ks) P.sa[ks] = *(const bf16x8*)(SST + 16 * ks);
    const size_t orow = (size_t)(row0 + 32 * tb + tl) * D + h * 128 + 32 * vb;
#pragma unroll
    for (int r4 = 0; r4 < 4; ++r4) { P.g[r4] = *(const u32x2*)(WSP(bf16_t, WS_GH) + orow + 8 * r4 + 4 * hh); P.gn[r4] = *(const f32x4*)(FIN(31) + 32 * vb + 8 * r4 + 4 * hh); }
}
__device__ __forceinline__ void hgc_unit(Frame& F, int unit, const HgcPre& P) {
    const int lane = F.lane, w = F.wave;
    const int bh = unit >> 5, n = unit & 31, b = bh >> 3, h = bh & 7;
    FLAS unsigned char* QM = F.lds, *KM = F.lds + 64 * HC_RS, *QHT = F.lds + 128 * HC_RS;
    FLAS float* part = (FLAS float*)(F.lds + 192 * HC_RS);
    FLAS unsigned char* vt = F.lds + 192 * HC_RS + 1024;
    const int row0 = b * T + n * 64;
#pragma unroll
    for (int i = 0; i < 2; ++i) { const int r = 8 * w + 4 * i + (lane >> 4), ch = lane & 15; *(FLAS u32x4*)(vt + r * VRS + 16 * ch) = P.v[i]; }
    {
        float bc[16], kk[16];
#pragma unroll
        for (int i = 0; i < 4; ++i) { const f32x4 v = P.lf[i]; bc[4 * i] = v[0]; bc[4 * i + 1] = v[1]; bc[4 * i + 2] = v[2]; bc[4 * i + 3] = v[3]; }
#pragma unroll
        for (int i = 0; i < 16; ++i) kk[i] = 1.0f - fast_exp(bc[i]);
#pragma unroll
        for (int i = 0; i < 16; ++i) {
            float x = bc[i];
            x += __builtin_bit_cast(float, __builtin_amdgcn_update_dpp(0, __builtin_bit_cast(int, x), 0x111, 0xf, 0xf, false));
            x += __builtin_bit_cast(float, __builtin_amdgcn_update_dpp(0, __builtin_bit_cast(int, x), 0x112, 0xf, 0xf, false));
            x += __builtin_bit_cast(float, __builtin_amdgcn_update_dpp(0, __builtin_bit_cast(int, x), 0x114, 0xf, 0xf, false));
            x += __builtin_bit_cast(float, __builtin_amdgcn_update_dpp(0, __builtin_bit_cast(int, x), 0x118, 0xf, 0xf, false));
            const float r0 = __builtin_bit_cast(float, __builtin_amdgcn_readlane(__builtin_bit_cast(int, x), 15)), r1 = __builtin_bit_cast(float, __builtin_amdgcn_readlane(__builtin_bit_cast(int, x), 31)),
                        r2 = __builtin_bit_cast(float, __builtin_amdgcn_readlane(__builtin_bit_cast(int, x), 47));
            const int rw = lane >> 4;
            bc[i] = x + (rw >= 1 ? r0 : 0.f) + (rw >= 2 ? r1 : 0.f) + (rw >= 3 ? r2 : 0.f);
        }
        const u32x4 qw0 = P.q[0], qw1 = P.q[1];
        float q[16];
        q[0] = bflo(qw0.x); q[1] = bfhi(qw0.x); q[2] = bflo(qw0.y); q[3] = bfhi(qw0.y); q[4] = bflo(qw0.z); q[5] = bfhi(qw0.z); q[6] = bflo(qw0.w); q[7] = bfhi(qw0.w);
        q[8] = bflo(qw1.x); q[9] = bfhi(qw1.x); q[10] = bflo(qw1.y); q[11] = bfhi(qw1.y); q[12] = bflo(qw1.z); q[13] = bfhi(qw1.z); q[14] = bflo(qw1.w); q[15] = bfhi(qw1.w);
        float qm[16], km[16], qh[16];
#pragma unroll
        for (int i = 0; i < 16; ++i) { const float bm = __shfl(bc[i], 31); qm[i] = q[i] * fast_exp(bc[i] - bm); km[i] = kk[i] * fast_exp(bm - bc[i]); qh[i] = q[i] * fast_exp(bc[i]); }
#define HC_PACK8(a, o_) ((u32x4){pk2(a[o_], a[o_ + 1]), pk2(a[o_ + 2], a[o_ + 3]), pk2(a[o_ + 4], a[o_ + 5]), pk2(a[o_ + 6], a[o_ + 7])})
        *(FLAS u32x4*)(QM + lane * HC_RS + 32 * w) = HC_PACK8(qm, 0); *(FLAS u32x4*)(QM + lane * HC_RS + 32 * w + 16) = HC_PACK8(qm, 8);
        *(FLAS u32x4*)(KM + lane * HC_RS + 32 * w) = HC_PACK8(km, 0); *(FLAS u32x4*)(KM + lane * HC_RS + 32 * w + 16) = HC_PACK8(km, 8);
        *(FLAS u32x4*)(QHT + lane * HC_RS + 32 * w) = HC_PACK8(qh, 0); *(FLAS u32x4*)(QHT + lane * HC_RS + 32 * w + 16) = HC_PACK8(qh, 8);
    }
    asm volatile("s_waitcnt lgkmcnt(0)" ::: "memory"); __builtin_amdgcn_s_barrier(); asm volatile("" ::: "memory");
    const int tb = w & 1, vb = w >> 1, tl = lane & 31, hh = lane >> 5, tglob = 32 * tb + tl;
    f32x16 acc = {};
#pragma unroll
    for (int ks = 0; ks < 8; ++ks) { const bf16x8 bq = *(const FLAS bf16x8*)(QHT + tglob * HC_RS + 32 * ks + 16 * hh);
        acc = __builtin_amdgcn_mfma_f32_32x32x16_bf16(P.sa[ks], bq, acc, 0, 0, 0); }
#pragma unroll
    for (int sb = 0; sb < 2; ++sb) {
        if (sb <= tb) {
            f32x16 x = {};
#pragma unroll
            for (int ks = 0; ks < 8; ++ks) { const bf16x8 a = *(const FLAS bf16x8*)(KM + (32 * sb + tl) * HC_RS + 32 * ks + 16 * hh); const bf16x8 bq = *(const FLAS bf16x8*)(QM + tglob * HC_RS + 32 * ks + 16 * hh);
                x = __builtin_amdgcn_mfma_f32_32x32x16_bf16(a, bq, x, 0, 0, 0); }
            if (sb == tb) {
#pragma unroll
                for (int r = 0; r < 16; ++r) if (crow(r, hh) > tl) x[r] = 0.f;
            }
#pragma unroll
            for (int s2 = 0; s2 < 2; ++s2) { u32x4 wv; wv.x = pk2(x[8 * s2], x[8 * s2 + 1]); wv.y = pk2(x[8 * s2 + 2], x[8 * s2 + 3]); wv.z = pk2(x[8 * s2 + 4], x[8 * s2 + 5]); wv.w = pk2(x[8 * s2 + 6], x[8 * s2 + 7]);
                const bf16x8 a = vt_frag(vt, vb, 2 * sb + s2, lane);
                acc = __builtin_amdgcn_mfma_f32_32x32x16_bf16(a, __builtin_bit_cast(bf16x8, wv), acc, 0, 0, 0); }
        }
    }
    float sq = 0.f;
#pragma unroll
    for (int r = 0; r < 16; ++r) sq += acc[r] * acc[r];
    sq += __shfl_xor(sq, 32);
    if (hh == 0) part[vb * 64 + tglob] = sq;
    asm volatile("s_waitcnt lgkmcnt(0)" ::: "memory"); __builtin_amdgcn_s_barrier(); asm volatile("" ::: "memory");
    const float tot = (part[tglob] + part[64 + tglob]) + (part[128 + tglob] + part[192 + tglob]);
    const float rs = 1.0f / sqrtf(tot * (1.0f / 128.0f) + EPS);
    const size_t orow = (size_t)(row0 + tglob) * D + h * 128 + 32 * vb;
#pragma unroll
    for (int r4 = 0; r4 < 4; ++r4) { const int v0 = 8 * r4 + 4 * hh;
        const u32x2 gw = P.g[r4]; const f32x4 gn = P.gn[r4];
        u32x2 wv; wv.x = pk2(acc[4 * r4] * rs * gn[0] * bflo(gw.x), acc[4 * r4 + 1] * rs * gn[1] * bfhi(gw.x)); wv.y = pk2(acc[4 * r4 + 2] * rs * gn[2] * bflo(gw.y), acc[4 * r4 + 3] * rs * gn[3] * bfhi(gw.y));
        *(u32x2*)(WSP(bf16_t, WS_AB) + orow + v0) = wv; }
    asm volatile("s_waitcnt lgkmcnt(0)" ::: "memory"); __builtin_amdgcn_s_barrier(); asm volatile("" ::: "memory");
}
__device__ __forceinline__ void phase_hgc(Frame& F) {
    HgcPre P; int u = F.vcu;
    if (u < 2048) hgc_prefetch(F, u, P);
    for (; u < 2048; u += F.G) {
        const HgcPre C = P; const int un = u + F.G;
        if (un < 2048) hgc_prefetch(F, un, P);
        __builtin_amdgcn_sched_barrier(0);
        hgc_unit(F, u, C);
    }
}
__device__ __forceinline__ void hg_sample_wave(Frame& F, int unit) {
    const int lane = F.lane, b = unit >> 3, h = unit & 7, v4 = lane & 31, kp = lane >> 5;
    const size_t rowo = (size_t)(MP + b) * D + h * 128;
    const float* S0 = FIN(5) + ((size_t)unit * 128) * 128 + 4 * v4; float* So = F.out + O_HG_S + ((size_t)unit * 128) * 128 + 4 * v4;
    const f32x2 lfp = *(const f32x2*)(WSP(float, WS_LOGF) + rowo + 2 * lane);
    const unsigned qp = *(const unsigned*)(WSP(bf16_t, WS_QB) + rowo + 2 * lane);
    const u32x2 vw_ = *(const u32x2*)(WSP(bf16_t, WS_VT) + rowo + 4 * v4); const f32x4 vv = {bflo(vw_.x), bfhi(vw_.x), bflo(vw_.y), bfhi(vw_.y)};
    const u32x2 gw = *(const u32x2*)(WSP(bf16_t, WS_GH) + rowo + 4 * v4); const f32x4 gn = *(const f32x4*)(FIN(31) + 4 * v4);
    const float fx = fast_exp(lfp[0]), fy = fast_exp(lfp[1]), qx = bflo(qp), qy = bfhi(qp);
    f32x4 o = {0.f, 0.f, 0.f, 0.f};
    f32x4 sbuf[2][16];
#pragma unroll
    for (int s = 0; s < 2; ++s)
#pragma unroll
        for (int i = 0; i < 16; ++i) sbuf[s][i] = __builtin_nontemporal_load((const f32x4*)(S0 + (size_t)(32 * s + 2 * i + kp) * 128));
#pragma unroll
    for (int it = 0; it < 4; ++it) {
        __builtin_amdgcn_sched_barrier(0);
#pragma unroll
        for (int i = 0; i < 16; ++i) { const int src = 16 * it + i;
            const float f0 = __builtin_bit_cast(float, __builtin_amdgcn_readlane(__builtin_bit_cast(int, fx), src)), f1 = __builtin_bit_cast(float, __builtin_amdgcn_readlane(__builtin_bit_cast(int, fy), src));
            const float q0 = __builtin_bit_cast(float, __builtin_amdgcn_readlane(__builtin_bit_cast(int, qx), src)), q1 = __builtin_bit_cast(float, __builtin_amdgcn_readlane(__builtin_bit_cast(int, qy), src));
            const float f = kp ? f1 : f0, q = kp ? q1 : q0, kk = 1.0f - f;
            const f32x4 sn = sbuf[it & 1][i] * f + vv * kk;
            __builtin_nontemporal_store(sn, (f32x4*)(So + (size_t)(32 * it + 2 * i + kp) * 128)); o = o + sn * q; }
        __builtin_amdgcn_sched_barrier(0);
        if (it + 2 < 4) {
#pragma unroll
            for (int i = 0; i < 16; ++i) sbuf[it & 1][i] = __builtin_nontemporal_load((const f32x4*)(S0 + (size_t)(32 * (it + 2) + 2 * i + kp) * 128)); }
    }
#pragma unroll
    for (int j = 0; j < 4; ++j) o[j] += __shfl_xor(o[j], 32);
    float sq = (o[0] * o[0] + o[1] * o[1]) + (o[2] * o[2] + o[3] * o[3]);
    sq += __shfl_xor(sq, 1); sq += __shfl_xor(sq, 2); sq += __shfl_xor(sq, 4); sq += __shfl_xor(sq, 8); sq += __shfl_xor(sq, 16);
    const float rs = 1.0f / sqrtf(sq * (1.0f / 128.0f) + EPS);
    if (kp == 0) { u32x2 wv; wv.x = pk2(o[0] * rs * gn[0] * bflo(gw.x), o[1] * rs * gn[1] * bfhi(gw.x)); wv.y = pk2(o[2] * rs * gn[2] * bflo(gw.y), o[3] * rs * gn[3] * bfhi(gw.y));
        *(u32x2*)(WSP(bf16_t, WS_AB) + rowo + 4 * v4) = wv; }
}
__device__ __forceinline__ void phase_final(Frame& F) {
    const int gw = F.vcu * NWAVES + F.wave, NGW = F.G * NWAVES, lane = F.lane;
    const bf16_t* XBp = WSP(bf16_t, WS_XB); const float* SSQ = WSP(float, WS_SSQ); const float* SSQS = WSP(float, WS_SSQS); const float* g = FIN(33);
    f32x4 gv[2][2];
#pragma unroll
    for (int j = 0; j < 2; ++j) { gv[j][0] = ((const f32x4*)g)[2 * (lane + 64 * j)]; gv[j][1] = ((const f32x4*)g)[2 * (lane + 64 * j) + 1]; }
    for (int row = gw; row < R; row += NGW) {
        const float part = row < MP ? (lane < 16 ? SSQ[(size_t)row * 32 + lane] : 0.f) : SSQS[(size_t)(row - MP) * 64 + lane];
        u32x4 xv[2];
#pragma unroll
        for (int j = 0; j < 2; ++j) xv[j] = ((const u32x4*)(XBp + (size_t)row * D))[lane + 64 * j];
        __builtin_amdgcn_sched_barrier(0);
        const float rs = 1.0f / sqrtf(wave_sum(part) * (1.0f / D) + EPS);
#pragma unroll
        for (int j = 0; j < 2; ++j) { f32x4 v0, v1; bf8_to_f32(xv[j], v0, v1);
            __builtin_nontemporal_store(v0 * rs * gv[j][0], (f32x4*)(F.out + (size_t)row * D) + 2 * (lane + 64 * j)); __builtin_nontemporal_store(v1 * rs * gv[j][1], (f32x4*)(F.out + (size_t)row * D) + 2 * (lane + 64 * j) + 1); }
    }
}
constexpr int NPHASE = 24;
#ifndef PHM
#define PHM 0xFFFFFFu
#endif
#define PHON(k) (((PHM) >> (k)) & 1u)
__global__ void __launch_bounds__(NTHR, 2) mega(Args args) {
    extern __shared__ __attribute__((aligned(16))) unsigned char lds_raw[];
    Frame F;
    F.lds = (FLAS unsigned char*)lds_raw;
    F.tid = threadIdx.x; F.lane = F.tid & 63; F.wave = __builtin_amdgcn_readfirstlane(F.tid >> 6);
    const int wave_s = F.wave;
    F.G = gridDim.x; { const int bx = blockIdx.x; F.vcu = (F.G % 8 == 0) ? (bx % 8) * (F.G / 8) + bx / 8 : bx; }
    { KAS const char* ka0 = (KAS const char*)__builtin_amdgcn_kernarg_segment_ptr(); F.ka = ka0; F.out = *(float* KAS const*)(ka0 + 272); F.ws = *(unsigned char* KAS const*)(ka0 + 280); }
    volatile FLAS unsigned* MISC = (volatile FLAS unsigned*)(F.lds + MISC_OFF);
    for (int u = F.tid; u < (LDS_BYTES - LDSCTL_OFF) / 4; u += NTHR) ((FLAS unsigned*)(F.lds + LDSCTL_OFF))[u] = 0u;
    __syncthreads();
    XcdBarrier bar = xcd_barrier_post((unsigned*)(F.ws + WS_CTL) + 4096 + args.ph_lo * XCD_BAR_WORDS, MISC + 8, F.tid == 0);
    const int bx0 = (int)blockIdx.x, G0 = F.G, vcu0 = F.vcu;
#if defined(REPM)
    int rl_ = -1;
#endif
#if defined(PHT)
    unsigned long long pht_acc_ = 0ull;
#endif
#pragma nounroll
    for (int ph = args.ph_lo; ph < args.ph_hi; ++ph) {
        int bx = bx0, G_ = G0, vcu_ = vcu0, wv_ = wave_s;
        asm volatile("" : "+s"(bx), "+s"(G_), "+s"(vcu_), "+s"(wv_));
        F.G = G_; F.vcu = vcu_;
        { int l_ = (int)__builtin_amdgcn_mbcnt_hi(~0u, __builtin_amdgcn_mbcnt_lo(~0u, 0u)); asm volatile("" : "+v"(l_)); F.lane = l_; F.wave = wv_; F.tid = wv_ * 64 + l_;
          KAS const char* ka_ = (KAS const char*)__builtin_amdgcn_kernarg_segment_ptr(); asm volatile("" : "+s"(ka_)); F.ka = ka_;
          F.out = *(float* KAS const*)(ka_ + 272); F.ws = *(unsigned char* KAS const*)(ka_ + 280); }
        bf16_t* XB = WSP(bf16_t, WS_XB); float* SSQ = WSP(float, WS_SSQ); float* SSQS = WSP(float, WS_SSQS); bf16_t* HB = WSP(bf16_t, WS_HB); bf16_t* AB = WSP(bf16_t, WS_AB); bf16_t* QB = WSP(bf16_t, WS_QB);
        const int layer = ph >= 11 ? 1 : 0;
#if defined(PHT)
        const unsigned long long pt0_ = __builtin_amdgcn_s_memrealtime();
#endif
#define SKINNY(PAIRED_, KS_, NT_, EPI_, A_, BT_, NU_, NCU_) do { int ln_ = F.lane; asm volatile("" : "+v"(ln_)); const auto e_ = EPI_; const int ncu_ = (NCU_) < G_ ? (NCU_) : G_; if (G_ - 1 - bx < ncu_) for (int u_ = G_ - 1 - bx; u_ < (NU_); u_ += ncu_) skinny_unit<PAIRED_, KS_, NT_>(A_, BT_, u_, F.wave, ln_, F.lds, e_); } while (0)
        if (ph == 0) { if (PHON(0)) phase_prep(F); }
        else if (PHON(1) && (ph == 1 || ph == 9 || ph == 11 || ph == 21)) {
            const bool second = (ph == 9 || ph == 21);
            const bf16_t* Bt = WSP(bf16_t, (second ? WS_W2IN : WS_W1IN) + layer * W1IN_SZ);
            pg8::Gemm g{XB, Bt, MP, 2 * FF, D}; pg8::StaticOrder S; S.init(MP, 2 * FF, F.G, bx);
            EpiSwiglu<16> E{SSQ, HB};
            pg8::gemm_phase<EpiSwiglu<16>, pg8::StaticOrder, true, true>(F.lds, g, S, E, F.tid);
            if (PHON(20) && ph == 1) {
                pg8::Gemm g2{WSP(bf16_t, WS_MEMN), WSP(bf16_t, WS_WKV), 2048, 4096, D}; pg8::StaticOrder S2; S2.init(2048, 4096, F.G, F.G - 1 - bx);
                EpiMemKV E2{F.out, WSP(bf16_t, WS_KBM), WSP(bf16_t, WS_VTM)};
                pg8::gemm_phase<EpiMemKV, pg8::StaticOrder, true, true>(F.lds, g2, S2, E2, F.tid);
                {
                    int ln_ = F.lane; asm volatile("" : "+v"(ln_)); const SEpiSwiglu e_{SSQS, HB};
                    for (int u_ = bx; u_ < 4 * FF / 32; u_ += G_) skinny_unit<true, 8, 2>(XB, Bt, u_, F.wave, ln_, F.lds, e_); }
            } else SKINNY(true, 8, 2, (SEpiSwiglu{SSQS, HB}), XB, Bt, 4 * FF / 32, 128);
        } else if (PHON(2) && (ph == 2 || ph == 10 || ph == 12 || ph == 22 || ph == 8 || ph == 20 || ph == 17)) {
            const bool ffn = (ph == 2 || ph == 10 || ph == 12 || ph == 22);
            const bf16_t* A; const bf16_t* Bt; int K; float sc;
            if (ffn) { const bool second = (ph == 10 || ph == 22); A = HB; Bt = WSP(bf16_t, (second ? WS_W2OUT : WS_W1OUT) + layer * W1OUT_SZ); K = FF; sc = 0.5f; }
            else if (ph == 17) { A = AB; Bt = WSP(bf16_t, WS_WHGOUT); K = D; sc = 1.0f; }
            else { A = AB; Bt = WSP(bf16_t, WS_WO + layer * WQ_SZ); K = D; sc = 1.0f; }
#if defined(REPM)
            if (rl_ >= 0) sc = 0.f;
#endif
            pg8::Gemm g{A, Bt, MP, D, K}; pg8::StaticOrder S; S.init(MP, D, F.G, bx);
            EpiResid E{XB, SSQ, sc};
            pg8::gemm_phase<EpiResid, pg8::StaticOrder, true, true>(F.lds, g, S, E, F.tid);
            if (K == D) SKINNY(false, 8, 1, (SEpiResid{XB, SSQS, sc}), A, Bt, 4 * D / 16, 256); else SKINNY(false, 22, 1, (SEpiResid{XB, SSQS, sc}), A, Bt, 4 * D / 16, 256);
        } else if (PHON(3) && ph == 3) phase_s5<0>(F);
        else if (PHON(4) && ph == 4) phase_s5<1>(F);
        else if (PHON(5) && ph == 5) {
            pg8::Gemm g{AB, WSP(bf16_t, WS_WGLU), MP, 2 * D, D}; pg8::StaticOrder S; S.init(MP, 2 * D, F.G, bx);
            EpiGlu E{XB, SSQ};
            pg8::gemm_phase<EpiGlu, pg8::StaticOrder, true, true>(F.lds, g, S, E, F.tid);
            SKINNY(true, 8, 1, (SEpiGlu{XB, SSQS}), AB, WSP(bf16_t, WS_WGLU), 4 * D / 16, 256);
        } else if (PHON(6) && (ph == 6 || ph == 18)) {
            const bf16_t* Bt = WSP(bf16_t, WS_WQ + layer * WQ_SZ);
            pg8::Gemm g{XB, Bt, MP, D, D}; pg8::StaticOrder S; S.init(MP, D, F.G, bx);
            if (ph == 6) { EpiQ<32> E{SSQ, QB}; pg8::gemm_phase<EpiQ<32>, pg8::StaticOrder, true, true>(F.lds, g, S, E, F.tid); }
            else { EpiQ<16> E{SSQ, QB}; pg8::gemm_phase<EpiQ<16>, pg8::StaticOrder, true, true>(F.lds, g, S, E, F.tid); }
            SKINNY(false, 8, 1, (SEpiQ{SSQS, QB}), XB, Bt, 4 * D / 16, 256);
        } else if (PHON(7) && (ph == 7 || ph == 19)) phase_attn(F, layer);
        else if (PHON(13) && ph == 13) {
            pg8::Gemm g{XB, WSP(bf16_t, WS_WHGIN), MP, 4 * D, D}; pg8::StaticOrder S; S.init(MP, 4 * D, F.G, bx);
            EpiHgIn<16> E{SSQ, WSP(float, WS_LB), QB, WSP(float, WS_LOGF), WSP(bf16_t, WS_VT), WSP(bf16_t, WS_GH)};
            pg8::gemm_phase<EpiHgIn<16>, pg8::StaticOrder, true, true>(F.lds, g, S, E, F.tid);
            SKINNY(false, 8, 2, (SEpiHgIn{SSQS, WSP(float, WS_LB), QB, WSP(float, WS_LOGF), WSP(bf16_t, WS_VT), WSP(bf16_t, WS_GH)}), XB, WSP(bf16_t, WS_WHGIN), 4 * 4 * D / 32, 256);
        } else if (PHON(14) && ph == 14) { for (int u = F.vcu; u < 2048; u += F.G) hga_unit(F, u); }
        else if (PHON(15) && ph == 15) phase_hgb(F);
        else if (PHON(16) && ph == 16) {
#if defined(HGREP)
            for (int r_ = 0; r_ < (((HGREP) & 1) ? 2 : 0); ++r_) { asm volatile("" ::: "memory"); phase_hgc(F); }
            for (int r_ = 0; r_ < (((HGREP) & 2) ? 2 : 0); ++r_) { asm volatile("" ::: "memory"); for (int u = F.vcu * NWAVES + F.wave; u < 1024; u += F.G * NWAVES) hg_sample_wave(F, u); }
#endif
            phase_hgc(F); if (F.wave < 4) for (int u = F.vcu * 4 + F.wave; u < 1024; u += F.G * 4) hg_sample_wave(F, u); }
        else if (PHON(23) && ph == 23) phase_final(F);
#if defined(REPM)
        if (rl_ < 0) rl_ = (int)(((unsigned)(REPM) >> ph) & 1u) * (REPN);
        if (rl_ > 0) { --rl_; --ph; continue; }
        rl_ = -1;
#endif
        if (ph + 1 < args.ph_hi) xcd_barrier(bar, F.tid == 0);
#if defined(PHT)
        if (((unsigned)(PHT) >> ph) & 1u) pht_acc_ += __builtin_amdgcn_s_memrealtime() - pt0_;
#endif
    }
#if defined(PHT)
    if (blockIdx.x == 0) { const unsigned long long te_ = __builtin_amdgcn_s_memrealtime(); while (__builtin_amdgcn_s_memrealtime() - te_ < 4ull * pht_acc_) __builtin_amdgcn_s_sleep(8); }
#endif
}

static int g_grid = 0;
static inline bool launch_setup() {
    if (g_grid == 0) {
        int dev = 0, cus = 0, per_cu = 0;
        if (hipGetDevice(&dev) != hipSuccess || hipDeviceGetAttribute(&cus, hipDeviceAttributeMultiprocessorCount, dev) != hipSuccess) { fprintf(stderr, "kernel_launch: device query failed\n"); g_grid = -1; return false; }
        if (hipFuncSetAttribute((const void*)mega, hipFuncAttributeMaxDynamicSharedMemorySize, LDS_BYTES) != hipSuccess) { fprintf(stderr, "kernel_launch: hipFuncSetAttribute failed\n"); g_grid = -1; return false; }
        if (hipOccupancyMaxActiveBlocksPerMultiprocessor(&per_cu, (const void*)mega, NTHR, LDS_BYTES) != hipSuccess || per_cu < 1) { fprintf(stderr, "kernel_launch: occupancy query says %d blocks/CU\n", per_cu); }
        (void)hipGetLastError();
        g_grid = cus;
        fprintf(stderr, "kernel_launch: grid %d, occupancy query %d per CU\n", g_grid, per_cu);
    }
    return g_grid > 0;
}
static inline void launch_phases(void* const* d_in, float* out, void* d_ws, int lo, int hi, hipStream_t st) {
    Args a{};
    for (int i = 0; i < 34; ++i) a.in[i] = (const float*)d_in[i];
    a.out = out; a.ws = (unsigned char*)d_ws; a.ph_lo = lo; a.ph_hi = hi;
    hipLaunchKernelGGL(mega, dim3(g_grid), dim3(NTHR), LDS_BYTES, st, a);
}
}
#if defined(DBG_BUILD)
#define WS_NEED_MIB 1020
#else
#define WS_NEED_MIB 616
#endif
extern "C" void kernel_launch(void* const* d_in, const int* in_sizes, int n_in, void* d_out, int out_size, void* d_ws, size_t ws_size, hipStream_t stream) {
    if (n_in != 34 || out_size != 44236800 || ws_size < ((size_t)WS_NEED_MIB << 20)) { fprintf(stderr, "kernel_launch: unexpected sizes n_in=%d out=%d ws=%zu\n", n_in, out_size, ws_size); return; }
    if (!fk::launch_setup()) return;
    hipMemsetAsync((char*)d_ws + fk::WS_CTL, 0, fk::CTL_ZERO_BYTES, stream);
#if defined(DBG_BUILD)
    dbg::forward(d_in, (float*)d_out, (unsigned char*)d_ws, stream);
#else
    fk::launch_phases(d_in, (float*)d_out, d_ws, 0, fk::NPHASE, stream);
#endif
}
```
